# Optimizing an MI355X kernel written in HIP

```python
import math
import jax, jax.numpy as jnp
from jax import lax
import numpy as np

D_MODEL = 1024
BATCH = 8
SEQ = 2048
DEPTH = 2

N_HEADS_A = 4
HEAD_DIM_A = 128
WIDTH_A = N_HEADS_A * HEAD_DIM_A
CONV_A = 4
CHUNK = 64
SSM_WIDTH = 512
SSM_GROUP = 16
N_GROUPS = SSM_WIDTH // SSM_GROUP
SSM_STATE = 64
D_IN_AB = 4 * WIDTH_A + 2 * N_HEADS_A + SSM_WIDTH
D_MIX_AB = WIDTH_A + SSM_WIDTH
POOL_WINDOWS = (2, 4, 8, 16)
POOL_GROUP = D_MODEL // len(POOL_WINDOWS)
MEM_LEN = 256
N_HEADS_X = 4
HEAD_DIM_X = D_MODEL // N_HEADS_X
D_FF = 2816
CONV_FFN = 3
RMS_EPS = 1e-6
N_EVEN = (DEPTH + 1) // 2
N_ODD = DEPTH // 2

kernel_name = "hybrid_deltanet_s5_pool_decoder"


def rms_norm(x, g):
    xf = x.astype(jnp.float32)
    y = xf * lax.rsqrt(jnp.mean(xf * xf, axis=-1, keepdims=True) + RMS_EPS)
    return (y * g.astype(jnp.float32)).astype(x.dtype)


def causal_dwconv(x, w):
    k_w = w.shape[0]
    t = x.shape[1]
    xp = jnp.pad(x, ((0, 0), (k_w - 1, 0), (0, 0)))
    return sum(xp[:, i:i + t, :] * w[i] for i in range(k_w))


def l2_normalize(x):
    return x * lax.rsqrt(jnp.sum(x * x, axis=-1, keepdims=True) + 1e-6)


def gated_delta_rule_chunked(q, k, v, g, beta):
    b, h, t, dk = q.shape
    dv = v.shape[-1]
    n = t // CHUNK
    q = q * (dk ** -0.5)
    q, k, v = (a.reshape(b, h, n, CHUNK, a.shape[-1]) for a in (q, k, v))
    g = jnp.cumsum(g.reshape(b, h, n, CHUNK), axis=-1)
    beta = beta.reshape(b, h, n, CHUNK)
    causal = jnp.tril(jnp.ones((CHUNK, CHUNK), bool))
    strict = jnp.tril(jnp.ones((CHUNK, CHUNK), bool), -1)
    diff = g[..., :, None] - g[..., None, :]
    decay = jnp.where(causal, jnp.exp(jnp.where(causal, diff, 0.0)), 0.0)
    k_beta = k * beta[..., None]
    a_mat = jnp.where(strict, jnp.einsum('bhncd,bhnsd->bhncs', k_beta, k) * decay, 0.0)
    eye = jnp.eye(CHUNK, dtype=jnp.float32)
    rhs = jnp.concatenate([v * beta[..., None], k_beta * jnp.exp(g)[..., None]], axis=-1)
    sol = lax.linalg.triangular_solve(a_mat + eye, rhs, left_side=True, lower=True,
                                      unit_diagonal=True)
    u, w = sol[..., :dv], sol[..., dv:]
    qk = jnp.where(causal, jnp.einsum('bhncd,bhnsd->bhncs', q, k) * decay, 0.0)

    def step(state, xs):
        q_c, k_c, u_c, w_c, qk_c, g_c = xs
        v_new = u_c - jnp.einsum('bhck,bhkv->bhcv', w_c, state)
        o = (jnp.einsum('bhck,bhkv->bhcv', q_c * jnp.exp(g_c)[..., None], state)
             + jnp.einsum('bhcs,bhsv->bhcv', qk_c, v_new))
        g_last = g_c[..., -1:]
        state = (state * jnp.exp(g_last)[..., None]
                 + jnp.einsum('bhck,bhcv->bhkv', k_c * jnp.exp(g_last - g_c)[..., None], v_new))
        return state, o

    xs = tuple(jnp.moveaxis(a, 2, 0) for a in (q, k, u, w, qk, g))
    s0 = jnp.zeros((b, h, dk, dv), jnp.float32)
    _, o = lax.scan(step, s0, xs)
    return jnp.moveaxis(o, 0, 2).reshape(b, h, t, dv)


def s5_ssm(u, lam_re, lam_im, b_re, b_im, c_re, c_im, d, log_dt):
    uf = u.astype(jnp.float32)
    dt = jnp.exp(log_dt.astype(jnp.float32))[:, None]
    lr, li = lam_re.astype(jnp.float32), lam_im.astype(jnp.float32)
    mag = jnp.exp(lr * dt)
    ang = li * dt
    lb_re, lb_im = mag * jnp.cos(ang), mag * jnp.sin(ang)
    den = lr * lr + li * li
    nr, ni = lb_re - 1.0, lb_im
    coef_re = (nr * lr + ni * li) / den
    coef_im = (ni * lr - nr * li) / den
    br, bi = b_re.astype(jnp.float32), b_im.astype(jnp.float32)
    bb_re = coef_re[..., None] * br - coef_im[..., None] * bi
    bb_im = coef_re[..., None] * bi + coef_im[..., None] * br
    bu_re = jnp.einsum('gph,btgh->btgp', bb_re, uf)
    bu_im = jnp.einsum('gph,btgh->btgp', bb_im, uf)
    a_re = jnp.broadcast_to(lb_re, bu_re.shape)
    a_im = jnp.broadcast_to(lb_im, bu_re.shape)

    def combine(e1, e2):
        a1r, a1i, b1r, b1i = e1
        a2r, a2i, b2r, b2i = e2
        return (a1r * a2r - a1i * a2i,
                a1r * a2i + a1i * a2r,
                a2r * b1r - a2i * b1i + b2r,
                a2r * b1i + a2i * b1r + b2i)

    _, _, xr, xi = lax.associative_scan(combine, (a_re, a_im, bu_re, bu_im), axis=1)
    y = (jnp.einsum('ghp,btgp->btgh', c_re.astype(jnp.float32), xr)
         - jnp.einsum('ghp,btgp->btgh', c_im.astype(jnp.float32), xi)
         + d.astype(jnp.float32) * uf)
    return y


def hybrid_delta_ssm_mixer(xn, w_in, conv_qkv, a_log, dt_bias, onorm_g,
                           lam_re, lam_im, b_re, b_im, c_re, c_im, ssm_d, log_dt,
                           w_glu, b_glu, w_out):
    b, t, _ = xn.shape
    h = xn @ w_in
    qkv, gate, beta_logit, alpha_logit, u = jnp.split(
        h, [3 * WIDTH_A, 4 * WIDTH_A, 4 * WIDTH_A + N_HEADS_A, 4 * WIDTH_A + 2 * N_HEADS_A],
        axis=-1)
    qkv = jax.nn.silu(causal_dwconv(qkv, conv_qkv)).astype(jnp.float32)
    q, k, v = (a.reshape(b, t, N_HEADS_A, HEAD_DIM_A).transpose(0, 2, 1, 3)
               for a in jnp.split(qkv, 3, axis=-1))
    q, k = l2_normalize(q), l2_normalize(k)
    beta = jax.nn.sigmoid(beta_logit.astype(jnp.float32)).transpose(0, 2, 1)
    g = (-jnp.exp(a_log.astype(jnp.float32))
         * jax.nn.softplus(alpha_logit.astype(jnp.float32) + dt_bias.astype(jnp.float32))
         ).transpose(0, 2, 1)
    o = gated_delta_rule_chunked(q, k, v, g, beta).transpose(0, 2, 1, 3)
    o = rms_norm(o, onorm_g) * jax.nn.silu(
        gate.reshape(b, t, N_HEADS_A, HEAD_DIM_A).astype(jnp.float32))
    y_a = o.reshape(b, t, WIDTH_A)
    y = s5_ssm(u.reshape(b, t, N_GROUPS, SSM_GROUP), lam_re, lam_im, b_re, b_im,
               c_re, c_im, ssm_d, log_dt)
    y = jax.nn.gelu(y.reshape(b, t, SSM_WIDTH))
    y_b = y * jax.nn.sigmoid(y @ w_glu.astype(jnp.float32) + b_glu.astype(jnp.float32))
    mixed = jnp.concatenate([y_a, y_b], axis=-1).astype(xn.dtype)
    return mixed @ w_out


def multiscale_pool_mixer(xn, pool_w, pool_scale):
    b, t, d = xn.shape
    xf = xn.astype(jnp.float32)
    cs = jnp.pad(lax.cumsum(xf, axis=1), ((0, 0), (1, 0), (0, 0)))
    pos_count = jnp.arange(1, t + 1, dtype=jnp.float32)[:, None]
    outs = []
    for gi, win in enumerate(POOL_WINDOWS):
        sl = slice(gi * POOL_GROUP, (gi + 1) * POOL_GROUP)
        csg = cs[..., sl]
        lower = jnp.pad(csg, ((0, 0), (win, 0), (0, 0)))[:, 1:t + 1]
        mean = (csg[:, 1:] - lower) / jnp.minimum(pos_count, float(win))
        outs.append(jnp.einsum('btc,ce->bte', mean - xf[..., sl],
                               pool_w[gi].astype(jnp.float32)))
    return (jnp.concatenate(outs, axis=-1) * pool_scale.astype(jnp.float32)).astype(xn.dtype)


def mem_cross_attention(xn, mem_n, wq, wkv, wo):
    b, t, _ = xn.shape
    m = mem_n.shape[1]
    q = (xn @ wq).reshape(b, t, N_HEADS_X, HEAD_DIM_X)
    kv = (mem_n @ wkv).reshape(b, m, 2, N_HEADS_X, HEAD_DIM_X)
    k, v = kv[:, :, 0], kv[:, :, 1]
    s = jnp.einsum('bthd,bmhd->bhtm', q, k).astype(jnp.float32) * (HEAD_DIM_X ** -0.5)
    p = jax.nn.softmax(s, axis=-1).astype(v.dtype)
    o = jnp.einsum('bhtm,bmhd->bthd', p, v).reshape(b, t, N_HEADS_X * HEAD_DIM_X)
    return o @ wo


def conv_ffn(xn, w_up, conv_w, w_down):
    h = causal_dwconv(xn @ w_up, conv_w)
    gate, val = jnp.split(h, 2, axis=-1)
    return (jax.nn.silu(gate) * val) @ w_down


def setup_inputs(seed: int = 0) -> dict:
    key = jax.random.key(seed)
    ks = iter(jax.random.split(key, 48))

    def nrm(shape, scale):
        return jax.random.normal(next(ks), shape, jnp.float32) * scale

    def gain(shape):
        return 1.0 + nrm(shape, 0.05)

    E, O, L, D = N_EVEN, N_ODD, DEPTH, D_MODEL
    x = nrm((BATCH, SEQ, D), 1.0)
    mem = nrm((BATCH, MEM_LEN, D), 1.0)
    norm_mix_g = gain((L, D))
    norm_xa_g = gain((L, D))
    norm_ffn_g = gain((L, D))
    norm_mem_g = gain((D,))
    norm_final_g = gain((D,))
    w_in_ab = nrm((E, D, D_IN_AB), D ** -0.5)
    conv_qkv_a = nrm((E, CONV_A, 3 * WIDTH_A), CONV_A ** -0.5)
    a_log_a = jnp.log(jax.random.uniform(next(ks), (E, N_HEADS_A), jnp.float32, 1.0, 16.0))
    dt0 = jnp.exp(jax.random.uniform(next(ks), (E, N_HEADS_A), jnp.float32,
                                     math.log(1e-3), math.log(1e-1)))
    dt_bias_a = dt0 + jnp.log(-jnp.expm1(-dt0))
    onorm_g_a = gain((E, HEAD_DIM_A))
    ssm_lambda_re = -0.5 + nrm((E, N_GROUPS, SSM_STATE), 0.01)
    ssm_lambda_im = jnp.broadcast_to(
        math.pi * jnp.arange(SSM_STATE, dtype=jnp.float32), (E, N_GROUPS, SSM_STATE)
    ) + nrm((E, N_GROUPS, SSM_STATE), 0.001)
    ssm_b_re = nrm((E, N_GROUPS, SSM_STATE, SSM_GROUP), (2 * SSM_GROUP) ** -0.5)
    ssm_b_im = nrm((E, N_GROUPS, SSM_STATE, SSM_GROUP), (2 * SSM_GROUP) ** -0.5)
    ssm_c_re = nrm((E, N_GROUPS, SSM_GROUP, SSM_STATE), (2 * SSM_STATE) ** -0.5)
    ssm_c_im = nrm((E, N_GROUPS, SSM_GROUP, SSM_STATE), (2 * SSM_STATE) ** -0.5)
    ssm_d = nrm((E, N_GROUPS, SSM_GROUP), 1.0)
    ssm_log_dt = jax.random.uniform(next(ks), (E, N_GROUPS), jnp.float32,
                                    math.log(1e-3), math.log(1e-1))
    w_glu_b = nrm((E, SSM_WIDTH, SSM_WIDTH), SSM_WIDTH ** -0.5)
    b_glu_b = nrm((E, SSM_WIDTH), 0.01)
    w_out_ab = nrm((E, D_MIX_AB, D), D_MIX_AB ** -0.5)
    pool_w = nrm((O, len(POOL_WINDOWS), POOL_GROUP, POOL_GROUP), POOL_GROUP ** -0.5)
    pool_scale = 1.0 + nrm((O, D), 0.1)
    xa_wq = nrm((L, D, D), D ** -0.5)
    xa_wkv = nrm((L, D, 2 * D), D ** -0.5)
    xa_wo = nrm((L, D, D), D ** -0.5)
    ffn_w_up = nrm((L, D, 2 * D_FF), D ** -0.5)
    ffn_conv = nrm((L, CONV_FFN, 2 * D_FF), 0.3) + jnp.array([0.0, 0.0, 1.0], jnp.float32)[None, :, None]
    ffn_w_down = nrm((L, D_FF, D), D_FF ** -0.5)
    return {
        "x": x, "mem": mem,
        "norm_mix_g": norm_mix_g, "norm_xa_g": norm_xa_g, "norm_ffn_g": norm_ffn_g,
        "norm_mem_g": norm_mem_g, "norm_final_g": norm_final_g,
        "w_in_ab": w_in_ab, "conv_qkv_a": conv_qkv_a, "a_log_a": a_log_a,
        "dt_bias_a": dt_bias_a, "onorm_g_a": onorm_g_a,
        "ssm_lambda_re": ssm_lambda_re, "ssm_lambda_im": ssm_lambda_im,
        "ssm_b_re": ssm_b_re, "ssm_b_im": ssm_b_im, "ssm_c_re": ssm_c_re, "ssm_c_im": ssm_c_im,
        "ssm_d": ssm_d, "ssm_log_dt": ssm_log_dt, "w_glu_b": w_glu_b, "b_glu_b": b_glu_b,
        "w_out_ab": w_out_ab,
        "pool_w": pool_w, "pool_scale": pool_scale,
        "xa_wq": xa_wq, "xa_wkv": xa_wkv, "xa_wo": xa_wo,
        "ffn_w_up": ffn_w_up, "ffn_conv": ffn_conv, "ffn_w_down": ffn_w_down,
    }


def reference(x, mem, norm_mix_g, norm_xa_g, norm_ffn_g, norm_mem_g, norm_final_g,
              w_in_ab, conv_qkv_a, a_log_a, dt_bias_a, onorm_g_a,
              ssm_lambda_re, ssm_lambda_im, ssm_b_re, ssm_b_im, ssm_c_re, ssm_c_im,
              ssm_d, ssm_log_dt, w_glu_b, b_glu_b, w_out_ab,
              pool_w, pool_scale, xa_wq, xa_wkv, xa_wo,
              ffn_w_up, ffn_conv, ffn_w_down):
    mem_n = rms_norm(mem, norm_mem_g)
    for layer in range(DEPTH):
        xn = rms_norm(x, norm_mix_g[layer])
        if layer % 2 == 0:
            e = layer // 2
            mix = hybrid_delta_ssm_mixer(
                xn, w_in_ab[e], conv_qkv_a[e], a_log_a[e], dt_bias_a[e], onorm_g_a[e],
                ssm_lambda_re[e], ssm_lambda_im[e], ssm_b_re[e], ssm_b_im[e],
                ssm_c_re[e], ssm_c_im[e], ssm_d[e], ssm_log_dt[e],
                w_glu_b[e], b_glu_b[e], w_out_ab[e])
        else:
            o = layer // 2
            mix = multiscale_pool_mixer(xn, pool_w[o], pool_scale[o])
        x = x + mix.astype(x.dtype)
        x = x + mem_cross_attention(rms_norm(x, norm_xa_g[layer]), mem_n,
                                    xa_wq[layer], xa_wkv[layer], xa_wo[layer]).astype(x.dtype)
        x = x + conv_ffn(rms_norm(x, norm_ffn_g[layer]),
                         ffn_w_up[layer], ffn_conv[layer], ffn_w_down[layer]).astype(x.dtype)
    return rms_norm(x, norm_final_g)
```

```cpp
#include <hip/hip_runtime.h>
#include <hip/hip_cooperative_groups.h>
#include <cstdio>
#include <cstdint>
namespace cg = cooperative_groups;

#define LAS __attribute__((address_space(3)))
typedef unsigned short bf16_t;
typedef short bf16x8 __attribute__((ext_vector_type(8)));
typedef float f32x4 __attribute__((ext_vector_type(4)));
typedef unsigned u32x4 __attribute__((ext_vector_type(4)));
typedef unsigned u32x2 __attribute__((ext_vector_type(2)));

constexpr int MT = 16384, DM = 1024, SEQ = 2048, NBATCH = 8;
constexpr int NIN = 2568, FF = 2816, FF2 = 5632;
constexpr float EPS = 1e-6f;
constexpr size_t HM = 524288;
constexpr size_t O_SSQ = 0;
constexpr size_t O_GL = 480 * 1024;
constexpr size_t O_WIN = 2 * HM;
constexpr size_t O_WGLU = 13 * HM;
constexpr size_t O_WOUT = 14 * HM;
constexpr size_t O_WQ = 18 * HM;
constexpr size_t O_WKV = 26 * HM;
constexpr size_t O_WO = 42 * HM;
constexpr size_t O_WUP = 50 * HM;
constexpr size_t O_WDN = 94 * HM;
constexpr size_t O_POOL = 116 * HM;
constexpr size_t O_MEMN = 117 * HM;
constexpr size_t O_KM = 125 * HM;
constexpr size_t O_VT = 141 * HM;
constexpr size_t O_XEND = 157 * HM;
constexpr size_t O_XPREV = 165 * HM;
constexpr size_t O_BA = 173 * HM;
constexpr size_t O_HALO = 174 * HM;
constexpr size_t O_XB = 186 * HM;
constexpr size_t O_R = 250 * HM;
constexpr size_t O_QKVRAW = O_R;
constexpr size_t O_GATE = O_R + 96 * HM;
constexpr size_t O_U = O_R + 128 * HM;
constexpr size_t O_DP2 = O_R + 160 * HM;
constexpr size_t O_DP1 = O_XB;
constexpr size_t O_ODELTA = O_R;
constexpr size_t O_YG = O_R + 64 * HM;
constexpr size_t O_MIXED = O_R + 160 * HM;
constexpr size_t O_Q = O_R;
constexpr size_t O_P = O_R + 64 * HM;
constexpr size_t O_O = O_R;
constexpr size_t O_ACT = O_R;
constexpr size_t O_DPOOL = O_R;
constexpr int LDS_BYTES = 147456;
constexpr int LDS_SCR = 131072;

struct Params { const float* in[31]; float* out; unsigned char* ws; int l_lo, l_hi; };
#define PH(k) (ONLYT < 0 || ONLYT == (k))

__device__ __forceinline__ unsigned f2bf(float f) { unsigned u = __float_as_uint(f); return (u + 0x7fffu + ((u >> 16) & 1u)) >> 16; }
__device__ __forceinline__ unsigned pk2(float lo, float hi) { return f2bf(lo) | (f2bf(hi) << 16); }
__device__ __forceinline__ float bflo(unsigned w) { return __uint_as_float(w << 16); }
__device__ __forceinline__ float bfhi(unsigned w) { return __uint_as_float(w & 0xffff0000u); }
__device__ __forceinline__ float bf1(bf16_t h) { return __uint_as_float(((unsigned)h) << 16); }
__device__ __forceinline__ float wave_sum(float v) {
#pragma unroll
    for (int o = 1; o < 64; o <<= 1) v += __shfl_xor(v, o);
    return v;
}
__device__ __forceinline__ int fresh_tid() { int t = threadIdx.x; asm volatile("" : "+v"(t)); return t; }
__device__ __forceinline__ float silu_f(float x) { return x * __builtin_amdgcn_rcpf(1.0f + __expf(-x)); }
__device__ __forceinline__ float sigmoid_f(float x) { return __builtin_amdgcn_rcpf(1.0f + __expf(-x)); }
__device__ __forceinline__ float gelu_tanh(float v) {
    const float z = 0.7978845608f * (v + 0.044715f * v * v * v);
    const float e = __expf(2.0f * z);
    const float th = 1.0f - 2.0f * __builtin_amdgcn_rcpf(e + 1.0f);
    return 0.5f * v * (1.0f + th);
}
template <int CTRL> __device__ __forceinline__ float dppf(float x) { return __int_as_float(__builtin_amdgcn_update_dpp(0, __float_as_int(x), CTRL, 0xf, 0xf, false)); }
template <int CTRL> __device__ __forceinline__ f32x4 dpp4(f32x4 x) { f32x4 r; r.x = dppf<CTRL>(x.x); r.y = dppf<CTRL>(x.y); r.z = dppf<CTRL>(x.z); r.w = dppf<CTRL>(x.w); return r; }
#define WG_BARRIER() do { asm volatile("s_waitcnt vmcnt(0) lgkmcnt(0)" ::: "memory"); __builtin_amdgcn_s_barrier(); asm volatile("" ::: "memory"); } while (0)
#define LDS_BARRIER() do { asm volatile("s_waitcnt lgkmcnt(0)" ::: "memory"); __builtin_amdgcn_s_barrier(); asm volatile("" ::: "memory"); } while (0)

namespace pg8 {
constexpr int BM = 256, BK = 64, HALF = 128, HTB = HALF * BK * 2;
__device__ __forceinline__ int lds_byte(int r, int c) { const int st = (r >> 4) * 2 + (c >> 5), rr = r & 15, cc = c & 31, ob = rr * 64 + cc * 2; return st * 1024 + (ob ^ (((ob >> 9) & 1) << 5)); }
__device__ __forceinline__ void stage_rc(int b, int& R, int& C) { const int st = b / 1024, sb = b % 1024, swz = sb ^ (((sb >> 9) & 1) << 5); R = (st >> 1) * 16 + swz / 64; C = (st & 1) * 32 + (swz % 64) / 2; }

struct Unit { const char* A; const char* B; int row0, col0, aux; };

__device__ __forceinline__ bool tile_order(int i, int G, int c, int nM, int nN, int& pm, int& pn) {
    const int nwg = nM * nN; const long L = (long)i * G + c; if (L >= nwg) return false;
    int wgid = (int)L; { const int q = nwg / 8, r = nwg % 8, xcd = wgid % 8, off = wgid / 8; wgid = (xcd < r ? xcd * (q + 1) : r * (q + 1) + (xcd - r) * q) + off; }
    const int nig = 8 * nN, gid = wgid / nig, fm = gid * 8, gsz = (nM - fm) < 8 ? (nM - fm) : 8;
    pm = fm + ((wgid % nig) % gsz); pn = (wgid % nig) / gsz; return true;
}

template <class Epi, class Sched>
__device__ __forceinline__ void gemm_phase(LAS unsigned char* lds, const int lda, const int ldb, const int K, const Sched& S, const Epi& E) {
    int tid_ = threadIdx.x; asm volatile("" : "+v"(tid_));
    const int tid = tid_, wid = __builtin_amdgcn_readfirstlane(tid >> 6), lane = tid & 63, wr = wid >> 2, wc = wid & 3, fr = lane & 15, fq = lane >> 4;
    const int nt = K / BK;
    unsigned voffA[2], voffB[2];
#pragma unroll
    for (int i = 0; i < 2; ++i) { int R, C; stage_rc(tid * 16 + i * 8192, R, C); voffA[i] = (unsigned)(R * lda + C) * 2u; voffB[i] = (unsigned)(R * ldb + C) * 2u; }
    const size_t kstep = (size_t)(BK * 2);
    const size_t hstepA = (size_t)HALF * lda * 2, hstepB = (size_t)HALF * ldb * 2;
    const unsigned ldsw = (unsigned)wid * 1024u;
    const int aoff = lds_byte(wr * 64 + fr, fq * 8), boff = lds_byte(wc * 32 + fr, fq * 8);
#define PG8_SA(b, h) (((b) * 2 + (h)) * HTB)
#define PG8_SB(b, h) ((4 + (b) * 2 + (h)) * HTB)
#define PG8_STAGE(bufoff, gbase, voff) do { _Pragma("unroll") for (int _i = 0; _i < 2; ++_i) \
        __builtin_amdgcn_global_load_lds((const unsigned*)((const char*)(gbase) + (voff)[_i]), (LAS unsigned*)(lds + (bufoff) + ldsw + _i * 8192), 16, 0, 0); } while (0)
#define PG8_LDA(dst, b, h) do { _Pragma("unroll") for (int m = 0; m < 4; ++m) _Pragma("unroll") for (int k = 0; k < 2; ++k) dst[m][k] = *(const LAS bf16x8*)(lds + PG8_SA(b, h) + aoff + m * 2048 + k * 1024); } while (0)
#define PG8_LDB(dst, b, h) do { _Pragma("unroll") for (int n = 0; n < 2; ++n) _Pragma("unroll") for (int k = 0; k < 2; ++k) dst[n][k] = *(const LAS bf16x8*)(lds + PG8_SB(b, h) + boff + n * 2048 + k * 1024); } while (0)
#define PG8_MMA(ai, bj, At, Bt) do { __builtin_amdgcn_s_setprio(1); _Pragma("unroll") for (int m = 0; m < 4; ++m) _Pragma("unroll") for (int n = 0; n < 2; ++n) _Pragma("unroll") for (int k = 0; k < 2; ++k) \
        acc[ai][bj][m][n] = __builtin_amdgcn_mfma_f32_16x16x32_bf16(Bt[n][k], At[m][k], acc[ai][bj][m][n], 0, 0, 0); __builtin_amdgcn_s_setprio(0); } while (0)
#define PG8_WAIT_V(n) asm volatile("s_waitcnt vmcnt(" #n ")" ::: "memory")
#define PG8_WAIT_L(n) asm volatile("s_waitcnt lgkmcnt(" #n ")" ::: "memory")
#define PG8_BAR __builtin_amdgcn_s_barrier()
#define PG8_SCHED __builtin_amdgcn_sched_barrier(0)
    Unit cur, nxt; int ui = 0;
    if (!S.next(0, cur)) return;
    f32x4 acc[2][2][4][2];
#pragma unroll
    for (int a = 0; a < 2; ++a)
#pragma unroll
        for (int b = 0; b < 2; ++b)
#pragma unroll
            for (int m = 0; m < 4; ++m)
#pragma unroll
                for (int n = 0; n < 2; ++n) acc[a][b][m][n] = (f32x4){0.f, 0.f, 0.f, 0.f};
    bf16x8 At[4][2], B0[2][2], B1[2][2];
    const char* cA = cur.A; const char* cB = cur.B;
    PG8_STAGE(PG8_SB(0, 0), cB, voffB); PG8_STAGE(PG8_SB(0, 1), cB + hstepB, voffB); PG8_STAGE(PG8_SA(0, 0), cA, voffA); PG8_STAGE(PG8_SA(0, 1), cA + hstepA, voffA);
    if (wr == 1) PG8_BAR;
    PG8_WAIT_V(2); PG8_BAR;
    PG8_STAGE(PG8_SB(1, 0), cB + kstep, voffB); PG8_STAGE(PG8_SA(1, 0), cA + kstep, voffA); PG8_STAGE(PG8_SB(1, 1), cB + hstepB + kstep, voffB);
    PG8_WAIT_V(6); PG8_BAR;
    for (;;) {
        const bool has_next = S.next(ui + 1, nxt);
        const char* nA = has_next ? nxt.A : cA; const char* nB = has_next ? nxt.B : cB;
#pragma unroll 1
        for (int t = 0; t < nt; t += 2) {
            const bool last = (t == nt - 2);
            const char* a1 = cA + (size_t)(t + 1) * kstep;
            const char* a2 = last ? nA : cA + (size_t)(t + 2) * kstep; const char* b2 = last ? nB : cB + (size_t)(t + 2) * kstep;
            const char* a3 = a2 + kstep; const char* b3 = b2 + kstep;
            PG8_LDB(B0, 0, 0); PG8_LDB(B1, 0, 1); PG8_SCHED; PG8_LDA(At, 0, 0); PG8_STAGE(PG8_SA(1, 1), a1 + hstepA, voffA);
            PG8_WAIT_V(8); PG8_WAIT_L(0); PG8_BAR; PG8_MMA(0, 0, At, B0); PG8_MMA(0, 1, At, B1); PG8_BAR; PG8_SCHED;
            PG8_LDA(At, 0, 1); PG8_STAGE(PG8_SB(0, 0), b2, voffB); PG8_STAGE(PG8_SB(0, 1), b2 + hstepB, voffB); PG8_STAGE(PG8_SA(0, 0), a2, voffA);
            PG8_WAIT_V(8); PG8_WAIT_L(0); PG8_BAR; PG8_MMA(1, 0, At, B0); PG8_MMA(1, 1, At, B1); PG8_BAR; PG8_SCHED;
            PG8_LDB(B0, 1, 0); PG8_LDB(B1, 1, 1); PG8_SCHED; PG8_LDA(At, 1, 0); PG8_STAGE(PG8_SA(0, 1), a2 + hstepA, voffA);
            PG8_WAIT_V(8); PG8_WAIT_L(0); PG8_BAR; PG8_MMA(0, 0, At, B0); PG8_MMA(0, 1, At, B1); PG8_BAR; PG8_SCHED;
            PG8_LDA(At, 1, 1); PG8_STAGE(PG8_SB(1, 0), b3, voffB); PG8_STAGE(PG8_SB(1, 1), b3 + hstepB, voffB); PG8_STAGE(PG8_SA(1, 0), a3, voffA);
            PG8_WAIT_V(8); PG8_WAIT_L(0); PG8_BAR; PG8_MMA(1, 0, At, B0); PG8_MMA(1, 1, At, B1); PG8_BAR; PG8_SCHED;
        }
        if (wr == 0) PG8_BAR;
        { int efr = fr, efq = fq; asm volatile("" : "+v"(efr), "+v"(efq)); E(acc, cur, wr, wc, efr, efq, lds); }
        if (!has_next) break;
#pragma unroll
        for (int a = 0; a < 2; ++a)
#pragma unroll
            for (int b = 0; b < 2; ++b)
#pragma unroll
                for (int m = 0; m < 4; ++m)
#pragma unroll
                    for (int n = 0; n < 2; ++n) acc[a][b][m][n] = (f32x4){0.f, 0.f, 0.f, 0.f};
        cur = nxt; cA = nA; cB = nB; ++ui;
        if (wr == 1) PG8_BAR;
    }
    PG8_WAIT_V(0);
    PG8_BAR;
#undef PG8_SA
#undef PG8_SB
#undef PG8_STAGE
#undef PG8_LDA
#undef PG8_LDB
#undef PG8_MMA
#undef PG8_WAIT_V
#undef PG8_WAIT_L
#undef PG8_BAR
#undef PG8_SCHED
}

struct SchedPlain {
    const char* A; const char* B; int lda, ldb, nM, nN, G, c, acol, brow;
    __device__ __forceinline__ bool next(int i, Unit& u) const {
        int pm, pn; if (!tile_order(i, G, c, nM, nN, pm, pn)) return false;
        u.A = A + ((size_t)pm * 256 * lda + (size_t)pn * acol) * 2; u.B = B + (size_t)pn * brow * ldb * 2; u.row0 = pm * 256; u.col0 = pn * 256; u.aux = 0; return true;
    }
};
struct SchedAttn {
    const char* A; const char* B; int kind, G, c;
    __device__ __forceinline__ bool next(int i, Unit& u) const {
        const int L = i * G + c; if (L >= 256) return false;
        const int b = L >> 5, h = (L >> 3) & 3, qt = L & 7;
        u.row0 = b * 2048 + qt * 256; u.col0 = h * 256; u.aux = 0;
        u.A = A + ((size_t)u.row0 * 1024 + h * 256) * 2;
        u.B = kind == 0 ? B + ((size_t)(b * 256) * 1024 + h * 256) * 2 : B + ((size_t)(b * 1024 + h * 256) * 256) * 2;
        return true;
    }
};
struct SchedKV {
    const char* memn; const char* wkv; int G, c;
    __device__ __forceinline__ bool next(int i, Unit& u) const {
        const int L = i * G + c; if (L >= 128) return false;
        const int l = L >> 6, kind = (L >> 5) & 1, idx = L & 31; u.aux = l * 2 + kind;
        const char* w = wkv + (size_t)l * 2048 * 1024 * 2;
        if (kind == 0) { const int pm = idx >> 2, pn = idx & 3; u.A = memn + (size_t)pm * 256 * 1024 * 2; u.B = w + (size_t)pn * 256 * 1024 * 2; u.row0 = pm * 256; u.col0 = pn * 256; }
        else { const int b = idx >> 2, pm = idx & 3; u.A = w + (size_t)(1024 + pm * 256) * 1024 * 2; u.B = memn + (size_t)b * 256 * 1024 * 2; u.row0 = b * 1024 + pm * 256; u.col0 = 0; }
        return true;
    }
};

#define EPI_ARGS f32x4 (&acc)[2][2][4][2], const Unit& u, int wr, int wc, int fr, int fq, LAS unsigned char* lds
#define FOR_AI_M _Pragma("unroll") for (int ai = 0; ai < 2; ++ai) _Pragma("unroll") for (int m = 0; m < 4; ++m)
#define FOR_BJ_N _Pragma("unroll") for (int bj = 0; bj < 2; ++bj) _Pragma("unroll") for (int n = 0; n < 2; ++n)
__device__ __forceinline__ void st_bf4(bf16_t* p, f32x4 v) { u32x2 w; w.x = pk2(v.x, v.y); w.y = pk2(v.z, v.w); *(u32x2*)p = w; }

struct EpiWin {
    const float* ssq; bf16_t* qkv; bf16_t* gate; float* ba; bf16_t* uo;
    __device__ __forceinline__ void operator()(EPI_ARGS) const {
        FOR_AI_M { const int row = u.row0 + 128 * ai + 64 * wr + 16 * m + fr; const float rs = rsqrtf(ssq[row] * (1.0f / 1024.0f) + EPS);
            FOR_BJ_N { const int c = u.col0 + 128 * bj + 32 * wc + 16 * n + 4 * fq; const f32x4 v = acc[ai][bj][m][n] * rs;
                if (c < 1536) st_bf4(qkv + (size_t)row * 1536 + c, v);
                else if (c < 2048) st_bf4(gate + (size_t)row * 512 + (c - 1536), v);
                else if (c < 2056) *(f32x4*)(ba + (size_t)row * 8 + (c - 2048)) = v;
                else if (c < NIN) st_bf4(uo + (size_t)row * 512 + (c - 2056), v); } }
    }
};
struct EpiRes {
    float* X; bf16_t* XB; float* ssqn; const float* colscale;
    __device__ __forceinline__ void operator()(EPI_ARGS) const {
        FOR_AI_M { const int row = u.row0 + 128 * ai + 64 * wr + 16 * m + fr; float s = 0.f;
            FOR_BJ_N { const int c = u.col0 + 128 * bj + 32 * wc + 16 * n + 4 * fq; f32x4 a = acc[ai][bj][m][n];
                if (colscale) a = a * *(const f32x4*)(colscale + c);
                float* xp = X + (size_t)row * 1024 + c; const f32x4 x = *(const f32x4*)xp + a; *(f32x4*)xp = x; st_bf4(XB + (size_t)row * 1024 + c, x);
                s += (x.x * x.x + x.y * x.y) + (x.z * x.z + x.w * x.w); }
            s += __shfl_xor(s, 16); s += __shfl_xor(s, 32);
            if (fq == 0) atomicAdd(ssqn + row, s);
            asm volatile("" ::: "memory"); }
    }
};
struct EpiScaleBf {
    const float* ssq; bf16_t* out; int ldc; float scale;
    __device__ __forceinline__ void operator()(EPI_ARGS) const {
        FOR_AI_M { const int row = u.row0 + 128 * ai + 64 * wr + 16 * m + fr; const float rs = (ssq ? rsqrtf(ssq[row] * (1.0f / 1024.0f) + EPS) : 1.0f) * scale;
            FOR_BJ_N { const int c = u.col0 + 128 * bj + 32 * wc + 16 * n + 4 * fq; st_bf4(out + (size_t)row * ldc + c, acc[ai][bj][m][n] * rs); } }
    }
};
struct EpiKV {
    bf16_t* km; bf16_t* vt;
    __device__ __forceinline__ void operator()(EPI_ARGS) const {
        const int l = u.aux >> 1, kind = u.aux & 1; bf16_t* o = kind == 0 ? km + (size_t)l * 2048 * 1024 : vt + (size_t)l * 8192 * 256; const int ldc = kind == 0 ? 1024 : 256;
        FOR_AI_M { const int row = u.row0 + 128 * ai + 64 * wr + 16 * m + fr;
            FOR_BJ_N { const int c = u.col0 + 128 * bj + 32 * wc + 16 * n + 4 * fq; st_bf4(o + (size_t)row * ldc + c, acc[ai][bj][m][n]); } }
    }
};
struct EpiGlu {
    const bf16_t* yg; const float* bias; bf16_t* mixed;
    __device__ __forceinline__ void operator()(EPI_ARGS) const {
        FOR_AI_M { const int row = u.row0 + 128 * ai + 64 * wr + 16 * m + fr;
            FOR_BJ_N { const int c = u.col0 + 128 * bj + 32 * wc + 16 * n + 4 * fq; const f32x4 z = acc[ai][bj][m][n] + *(const f32x4*)(bias + c);
                const u32x2 yw = *(const u32x2*)(yg + (size_t)row * 512 + c); f32x4 o;
                o.x = bflo(yw.x) * sigmoid_f(z.x); o.y = bfhi(yw.x) * sigmoid_f(z.y); o.z = bflo(yw.y) * sigmoid_f(z.z); o.w = bfhi(yw.y) * sigmoid_f(z.w);
                st_bf4(mixed + (size_t)row * 1024 + 512 + c, o); } }
    }
};
struct EpiSoftmax {
    bf16_t* P;
    __device__ __forceinline__ void operator()(EPI_ARGS) const {
        LAS float* smax = (LAS float*)(lds + LDS_SCR); LAS float* ssum = smax + 1024;
        FOR_AI_M { const int rl = 128 * ai + 64 * wr + 16 * m + fr; float mx = -3.0e38f;
            FOR_BJ_N { const f32x4 v = acc[ai][bj][m][n]; mx = fmaxf(mx, fmaxf(fmaxf(v.x, v.y), fmaxf(v.z, v.w))); }
            mx = fmaxf(mx, __shfl_xor(mx, 16)); mx = fmaxf(mx, __shfl_xor(mx, 32));
            if (fq == 0) smax[rl * 4 + wc] = mx; }
        LDS_BARRIER();
        FOR_AI_M { const int rl = 128 * ai + 64 * wr + 16 * m + fr; const f32x4 mm = *(const LAS f32x4*)(smax + rl * 4);
            const float mx = fmaxf(fmaxf(mm.x, mm.y), fmaxf(mm.z, mm.w)); float s = 0.f;
            FOR_BJ_N { f32x4 v = acc[ai][bj][m][n]; v.x = __expf(v.x - mx); v.y = __expf(v.y - mx); v.z = __expf(v.z - mx); v.w = __expf(v.w - mx); acc[ai][bj][m][n] = v; s += (v.x + v.y) + (v.z + v.w); }
            s += __shfl_xor(s, 16); s += __shfl_xor(s, 32);
            if (fq == 0) ssum[rl * 4 + wc] = s; }
        LDS_BARRIER();
        FOR_AI_M { const int rl = 128 * ai + 64 * wr + 16 * m + fr; const int row = u.row0 + rl; const f32x4 ss = *(const LAS f32x4*)(ssum + rl * 4);
            const float inv = 1.0f / ((ss.x + ss.y) + (ss.z + ss.w));
            FOR_BJ_N { const int c = u.col0 + 128 * bj + 32 * wc + 16 * n + 4 * fq; st_bf4(P + (size_t)row * 1024 + c, acc[ai][bj][m][n] * inv); } }
    }
};
struct EpiUp {
    const float* ssq; const float* cw; bf16_t* act; float* halo;
    __device__ __forceinline__ void operator()(EPI_ARGS) const {
        LAS float* hl = (LAS float*)(lds + LDS_SCR);
        const int pm = u.row0 >> 8, pn = u.col0 >> 8;
        FOR_AI_M { const int row = u.row0 + 128 * ai + 64 * wr + 16 * m + fr; const float rs = rsqrtf(ssq[row] * (1.0f / 1024.0f) + EPS);
            FOR_BJ_N acc[ai][bj][m][n] = acc[ai][bj][m][n] * rs; }
#pragma unroll
        for (int ai = 0; ai < 2; ++ai) { const int strip = 2 * ai + wr;
            if (fr >= 14) { const int rr = fr - 14;
                FOR_BJ_N { const int lc = 128 * bj + 32 * wc + 16 * n + 4 * fq; *(LAS f32x4*)(hl + (strip * 2 + rr) * 256 + lc) = acc[ai][bj][3][n];
                    if (strip == 3) *(f32x4*)(halo + (size_t)(pm * 4 + 2 + rr) * FF2 + u.col0 + lc) = acc[ai][bj][3][n]; } }
            if (strip == 0 && fr < 2) { FOR_BJ_N { const int lc = 128 * bj + 32 * wc + 16 * n + 4 * fq; *(f32x4*)(halo + (size_t)(pm * 4 + fr) * FF2 + u.col0 + lc) = acc[ai][bj][0][n]; } } }
        LDS_BARRIER();
#pragma unroll
        for (int ai = 0; ai < 2; ++ai) { const int strip = 2 * ai + wr;
#pragma unroll
            for (int n = 0; n < 2; ++n) {
                const int lcg = 32 * wc + 16 * n + 4 * fq; const int ch = pn * 128 + lcg;
                const f32x4 wg0 = *(const f32x4*)(cw + ch), wg1 = *(const f32x4*)(cw + FF2 + ch), wg2 = *(const f32x4*)(cw + 2 * FF2 + ch);
                const f32x4 wv0 = *(const f32x4*)(cw + FF + ch), wv1 = *(const f32x4*)(cw + FF2 + FF + ch), wv2 = *(const f32x4*)(cw + 2 * FF2 + FF + ch);
                f32x4 hg1 = (f32x4){0.f, 0.f, 0.f, 0.f}, hg2 = hg1, hv1 = hg1, hv2 = hg1;
                if (strip > 0) { const LAS float* hp = hl + (strip - 1) * 512 + lcg; hg2 = *(const LAS f32x4*)hp; hg1 = *(const LAS f32x4*)(hp + 256); hv2 = *(const LAS f32x4*)(hp + 128); hv1 = *(const LAS f32x4*)(hp + 384); }
                f32x4 pg1 = hg1, pv1 = hv1, pg2 = (fr == 1) ? hg1 : hg2, pv2 = (fr == 1) ? hv1 : hv2;
#pragma unroll
                for (int m = 0; m < 4; ++m) {
                    const f32x4 g = acc[ai][0][m][n], v = acc[ai][1][m][n];
                    const f32x4 rg1 = dpp4<0x121>(g), rg2 = dpp4<0x122>(g), rv1 = dpp4<0x121>(v), rv2 = dpp4<0x122>(v);
                    const f32x4 g1 = fr >= 1 ? rg1 : pg1, g2 = fr >= 2 ? rg2 : pg2, v1 = fr >= 1 ? rv1 : pv1, v2 = fr >= 2 ? rv2 : pv2;
                    const f32x4 cg_ = wg2 * g + wg1 * g1 + wg0 * g2, cv_ = wv2 * v + wv1 * v1 + wv0 * v2;
                    f32x4 o; o.x = silu_f(cg_.x) * cv_.x; o.y = silu_f(cg_.y) * cv_.y; o.z = silu_f(cg_.z) * cv_.z; o.w = silu_f(cg_.w) * cv_.w;
                    const int row = u.row0 + 128 * ai + 64 * wr + 16 * m + fr;
                    st_bf4(act + (size_t)row * FF + ch, o);
                    pg1 = rg1; pg2 = rg2; pv1 = rv1; pv2 = rv2;
                } } }
    }
};
}

__device__ __forceinline__ void transpose_item(const float* W, int K, int N, bf16_t* WT, const float* gain, int mode, LAS float* scr, int item, int lane) {
    const int nblk = (N + 31) / 32, kb = item / nblk, nb = item % nblk, k0 = 64 * kb, n0 = 32 * nb;
    const int nn = n0 + (lane & 31);
#pragma unroll 8
    for (int i = 0; i < 32; ++i) { const int kk = 2 * i + (lane >> 5); float v = 0.f; if (nn < N) { v = W[(size_t)(k0 + kk) * N + nn]; if (gain) v *= gain[k0 + kk]; } scr[kk * 33 + (lane & 31)] = v; }
    asm volatile("s_waitcnt lgkmcnt(0)" ::: "memory");
    const int c = lane & 7;
    int rbase = n0;
    if (mode == 1) { const int isv = n0 >= FF ? 1 : 0; const int ch = n0 - isv * FF; rbase = (ch >> 7) * 256 + isv * 128 + (ch & 127); }
#pragma unroll
    for (int j = 0; j < 4; ++j) { const int n = (lane >> 3) + 8 * j; const LAS float* s = scr + (8 * c) * 33 + n;
        u32x4 o; o.x = pk2(s[0 * 33], s[1 * 33]); o.y = pk2(s[2 * 33], s[3 * 33]); o.z = pk2(s[4 * 33], s[5 * 33]); o.w = pk2(s[6 * 33], s[7 * 33]);
        *(u32x4*)(WT + (size_t)(rbase + n) * K + k0 + 8 * c) = o; }
    asm volatile("s_waitcnt lgkmcnt(0)" ::: "memory");
}

__device__ __forceinline__ void phase_prologue(const Params& p, LAS unsigned char* lds, int G) {
    const int tid = fresh_tid(), lane = tid & 63, wave = tid >> 6;
    LAS float* scr = (LAS float*)(lds + wave * 16384);
    const int gw = blockIdx.x * 8 + wave, NGW = G * 8;
    unsigned char* ws = p.ws;
    for (int mi = 0; mi < 17; ++mi) {
        const float* W; int K, N, mode = 0; bf16_t* WT; const float* gain = nullptr;
        switch (mi) {
            case 0: W = p.in[7]; K = 1024; N = NIN; WT = (bf16_t*)(ws + O_WIN); gain = p.in[2]; break;
            case 1: W = p.in[20]; K = 512; N = 512; WT = (bf16_t*)(ws + O_WGLU); break;
            case 2: W = p.in[22]; K = 1024; N = 1024; WT = (bf16_t*)(ws + O_WOUT); break;
            case 3: W = p.in[25]; K = 1024; N = 1024; WT = (bf16_t*)(ws + O_WQ); gain = p.in[3]; break;
            case 4: W = p.in[25] + 1024 * 1024; K = 1024; N = 1024; WT = (bf16_t*)(ws + O_WQ) + 1024 * 1024; gain = p.in[3] + 1024; break;
            case 5: W = p.in[26]; K = 1024; N = 2048; WT = (bf16_t*)(ws + O_WKV); break;
            case 6: W = p.in[26] + 1024 * 2048; K = 1024; N = 2048; WT = (bf16_t*)(ws + O_WKV) + 2048 * 1024; break;
            case 7: W = p.in[27]; K = 1024; N = 1024; WT = (bf16_t*)(ws + O_WO); break;
            case 8: W = p.in[27] + 1024 * 1024; K = 1024; N = 1024; WT = (bf16_t*)(ws + O_WO) + 1024 * 1024; break;
            case 9: W = p.in[28]; K = 1024; N = FF2; WT = (bf16_t*)(ws + O_WUP); gain = p.in[4]; mode = 1; break;
            case 10: W = p.in[28] + (size_t)1024 * FF2; K = 1024; N = FF2; WT = (bf16_t*)(ws + O_WUP) + (size_t)FF2 * 1024; gain = p.in[4] + 1024; mode = 1; break;
            case 11: W = p.in[30]; K = FF; N = 1024; WT = (bf16_t*)(ws + O_WDN); break;
            case 12: W = p.in[30] + (size_t)FF * 1024; K = FF; N = 1024; WT = (bf16_t*)(ws + O_WDN) + (size_t)1024 * FF; break;
            default: W = p.in[23] + (mi - 13) * 65536; K = 256; N = 256; WT = (bf16_t*)(ws + O_POOL) + (mi - 13) * 65536; break;
        }
        const int nitems = (K / 64) * ((N + 31) / 32);
        for (int it = gw; it < nitems; it += NGW) transpose_item(W, K, N, WT, gain, mode, scr, it, lane);
    }
    { u32x4* z = (u32x4*)((bf16_t*)(ws + O_WIN) + (size_t)2592 * 1024); const int n16 = 224 * 1024 * 2 / 16;
      for (int i = blockIdx.x * 512 + tid; i < n16; i += G * 512) z[i] = (u32x4){0u, 0u, 0u, 0u}; }
    { float* s = (float*)(ws + O_SSQ) + MT; for (int i = blockIdx.x * 512 + tid; i < 6 * MT; i += G * 512) s[i] = 0.f; }
    for (int r = gw; r < 2048; r += NGW) {
        const f32x4* xr = (const f32x4*)(p.in[1] + (size_t)r * 1024) + lane; const f32x4* gr = (const f32x4*)p.in[5] + lane;
        f32x4 v[4]; float s = 0.f;
#pragma unroll
        for (int j = 0; j < 4; ++j) { v[j] = xr[64 * j]; s += (v[j].x * v[j].x + v[j].y * v[j].y) + (v[j].z * v[j].z + v[j].w * v[j].w); }
        const float rs = rsqrtf(wave_sum(s) * (1.0f / 1024.0f) + EPS);
        bf16_t* o = (bf16_t*)(ws + O_MEMN) + (size_t)r * 1024;
#pragma unroll
        for (int j = 0; j < 4; ++j) pg8::st_bf4(o + (64 * j + lane) * 4, v[j] * rs * gr[64 * j]);
    }
    for (int r = gw; r < MT; r += NGW) {
        const f32x4* xr = (const f32x4*)(p.in[0] + (size_t)r * 1024) + lane; f32x4* xo = (f32x4*)(p.out + (size_t)r * 1024) + lane;
        bf16_t* o = (bf16_t*)(ws + O_XB) + (size_t)r * 1024; float s = 0.f;
#pragma unroll
        for (int j = 0; j < 4; ++j) { const f32x4 v = xr[64 * j]; xo[64 * j] = v; pg8::st_bf4(o + (64 * j + lane) * 4, v); s += (v.x * v.x + v.y * v.y) + (v.z * v.z + v.w * v.w); }
        s = wave_sum(s); if (lane == 0) ((float*)(ws + O_SSQ))[r] = s;
    }
}

__device__ __forceinline__ void delta_prep(const Params& p, LAS unsigned char* lds, int chunk) {
    const int tid = fresh_tid(), lane = tid & 63, wave = tid >> 6;
    const int c = chunk & 31, bh = chunk >> 5, h = bh & 3, b = bh >> 2;
    const int row0 = b * SEQ + c * 64;
    LAS float* qf = (LAS float*)lds;
    LAS float* kf = qf + 64 * 132;
    LAS float* vf = kf + 64 * 132;
    LAS float* Am = vf + 64 * 132;
    LAS float* gc = Am + 64 * 68;
    LAS float* bt = gc + 64;
    unsigned char* ws = p.ws;
    const bf16_t* raw = (const bf16_t*)(ws + O_QKVRAW);
    if (tid < 384) {
        const int quad = tid % 96, seg = tid / 96, part = quad >> 5, within = (quad & 31) * 4, gcol = part * 512 + h * 128 + within;
        const float* cwp = p.in[8] + gcol;
        const f32x4 w0 = *(const f32x4*)cwp, w1 = *(const f32x4*)(cwp + 1536), w2 = *(const f32x4*)(cwp + 3072), w3 = *(const f32x4*)(cwp + 4608);
        LAS float* dst = (part == 0 ? qf : (part == 1 ? kf : vf)) + within;
        const int t0 = seg * 16;
        f32x4 x0, x1, x2;
        {
            f32x4 xs[3];
#pragma unroll
            for (int k = 0; k < 3; ++k) { const int t = t0 - 3 + k; f32x4 v = (f32x4){0.f, 0.f, 0.f, 0.f};
                if (c * 64 + t >= 0) { const u32x2 w = *(const u32x2*)(raw + (size_t)(row0 + t) * 1536 + gcol); v = (f32x4){bflo(w.x), bfhi(w.x), bflo(w.y), bfhi(w.y)}; }
                xs[k] = v; }
            x0 = xs[0]; x1 = xs[1]; x2 = xs[2];
        }
#pragma unroll 4
        for (int t = t0; t < t0 + 16; ++t) {
            const u32x2 w = *(const u32x2*)(raw + (size_t)(row0 + t) * 1536 + gcol); const f32x4 x3 = (f32x4){bflo(w.x), bfhi(w.x), bflo(w.y), bfhi(w.y)};
            const f32x4 y = w0 * x0 + w1 * x1 + w2 * x2 + w3 * x3;
            f32x4 o; o.x = silu_f(y.x); o.y = silu_f(y.y); o.z = silu_f(y.z); o.w = silu_f(y.w);
            *(LAS f32x4*)(dst + t * 132) = o;
            x0 = x1; x1 = x2; x2 = x3;
        }
    } else if (wave == 6) {
        const float* ba = (const float*)(ws + O_BA) + (size_t)(row0 + lane) * 8;
        const float al = ba[4 + h] + p.in[10][h]; const float sp = al > 20.f ? al : log1pf(expf(al));
        float g = -expf(p.in[9][h]) * sp;
#pragma unroll
        for (int o = 1; o < 64; o <<= 1) { const float t = __shfl_up(g, o); if (lane >= o) g += t; }
        gc[lane] = g; bt[lane] = sigmoid_f(ba[h]);
        if (lane == 63) ((float*)(ws + O_GL))[chunk] = expf(g);
    }
    LDS_BARRIER();
    {
        const int r = tid >> 2, qr = tid & 3; LAS float* rp = (r < 64 ? qf + r * 132 : kf + (r - 64) * 132) + qr * 32;
        f32x4 v[8]; float s = 0.f;
#pragma unroll
        for (int j = 0; j < 8; ++j) { v[j] = *(const LAS f32x4*)(rp + 4 * j); s += (v[j].x * v[j].x + v[j].y * v[j].y) + (v[j].z * v[j].z + v[j].w * v[j].w); }
        s += __shfl_xor(s, 1); s += __shfl_xor(s, 2);
        const float sc = rsqrtf(s + 1e-6f) * (r < 64 ? 0.08838834764831845f : 1.0f);
#pragma unroll
        for (int j = 0; j < 8; ++j) *(LAS f32x4*)(rp + 4 * j) = v[j] * sc;
    }
    LDS_BARRIER();
    bf16_t* dp2 = (bf16_t*)(ws + O_DP2 + (size_t)chunk * 40960);
    bf16_t* dp1 = (bf16_t*)(ws + O_DP1 + (size_t)chunk * 32768);
    for (int job = wave; job < 32; job += 8) {
        const int isqk = job >> 4, ti = (job >> 2) & 3, tj = job & 3;
        const int fr = lane & 15, fq = lane >> 4;
        const LAS float* ap = (isqk ? qf : kf) + (16 * ti + fr) * 132 + fq;
        const LAS float* bp = kf + (16 * tj + fr) * 132 + fq;
        f32x4 acc = (f32x4){0.f, 0.f, 0.f, 0.f};
#pragma unroll 8
        for (int ks = 0; ks < 32; ++ks) acc = __builtin_amdgcn_mfma_f32_16x16x4f32(ap[4 * ks], bp[4 * ks], acc, 0, 0, 0);
        const int j = 16 * tj + fr; const float gj = gc[j];
#pragma unroll
        for (int r = 0; r < 4; ++r) { const int i = 16 * ti + 4 * fq + r; const float dec = __expf(gc[i] - gj);
            if (!isqk) { Am[j * 68 + i] = (j < i) ? acc[r] * dec * bt[i] : 0.f; }
            else { const float v = (j <= i) ? acc[r] * dec : 0.f;
                const int mt = i >> 4, ii = i & 15, ks2 = j >> 5, r32 = j & 31, jj = 4 * (r32 >> 4) + (r32 & 3), q = (r32 & 15) >> 2;
                dp2[16384 + ((mt * 2 + ks2) * 64 + ii + 16 * q) * 8 + jj] = (bf16_t)f2bf(v); } }
    }
    LDS_BARRIER();
    {
        const float gl = gc[63];
#pragma unroll 1
        for (int f = tid; f < 1024; f += 512) {
            const int ln = f & 63, ii = ln & 15, q = ln >> 4;
            {
                const int mt = f >> 8, ks = (f >> 6) & 3, i = 16 * mt + ii; const float e = __expf(gc[i]);
                const LAS float* s = qf + i * 132 + 32 * ks + 4 * q; const f32x4 lo = *(const LAS f32x4*)s, hi = *(const LAS f32x4*)(s + 16);
                u32x4 o; o.x = pk2(lo.x * e, lo.y * e); o.y = pk2(lo.z * e, lo.w * e); o.z = pk2(hi.x * e, hi.y * e); o.w = pk2(hi.z * e, hi.w * e);
                *(u32x4*)(dp2 + (size_t)f * 8) = o; }
            {
                const int mt8 = f >> 7, ks2 = (f >> 6) & 1, dk = 16 * mt8 + ii; float v[8];
#pragma unroll
                for (int jj = 0; jj < 8; ++jj) { const int s = 32 * ks2 + 16 * (jj >> 2) + 4 * q + (jj & 3); v[jj] = kf[s * 132 + dk] * __expf(gl - gc[s]); }
                u32x4 o; o.x = pk2(v[0], v[1]); o.y = pk2(v[2], v[3]); o.z = pk2(v[4], v[5]); o.w = pk2(v[6], v[7]);
                *(u32x4*)(dp2 + 8192 + (size_t)f * 8) = o; }
        }
    }
    LDS_BARRIER();
    if (tid < 256) {
        const int col = tid; LAS float* buf = col < 128 ? vf + col : kf + (col - 128); const bool isw = col >= 128;
#pragma unroll 1
        for (int bi = 0; bi < 4; ++bi) {
            float acc[16];
#pragma unroll
            for (int r = 0; r < 16; ++r) { const int i = 16 * bi + r; float v = buf[i * 132] * bt[i]; if (isw) v *= __expf(gc[i]); acc[r] = v; }
#pragma unroll 2
            for (int j = 0; j < 16 * bi; ++j) {
                const float xj = buf[j * 132]; const LAS f32x4* ap = (const LAS f32x4*)(Am + j * 68 + 16 * bi);
#pragma unroll
                for (int q4 = 0; q4 < 4; ++q4) { const f32x4 a = ap[q4]; acc[4 * q4 + 0] -= a.x * xj; acc[4 * q4 + 1] -= a.y * xj; acc[4 * q4 + 2] -= a.z * xj; acc[4 * q4 + 3] -= a.w * xj; }
            }
#pragma unroll
            for (int r = 0; r < 16; ++r) {
                const float xr = acc[r]; buf[(16 * bi + r) * 132] = xr;
                const LAS float* arow = Am + (16 * bi + r) * 68 + 16 * bi;
#pragma unroll
                for (int r2 = r + 1; r2 < 16; ++r2) acc[r2] -= arow[r2] * xr;
            }
        }
    }
    LDS_BARRIER();
#pragma unroll 1
    for (int f = tid; f < 1024; f += 512) {
        { const int i = f >> 4, c8 = (f & 15) * 8; const LAS float* s = vf + i * 132 + c8; const f32x4 lo = *(const LAS f32x4*)s, hi = *(const LAS f32x4*)(s + 4);
          u32x4 o; o.x = pk2(lo.x, lo.y); o.y = pk2(lo.z, lo.w); o.z = pk2(hi.x, hi.y); o.w = pk2(hi.z, hi.w);
          *(u32x4*)(dp1 + 8192 + i * 128 + c8) = o; }
        { const int ln = f & 63, ii = ln & 15, q = ln >> 4, mt = f >> 8, ks = (f >> 6) & 3, i = 16 * mt + ii;
          const LAS float* s = kf + i * 132 + 32 * ks + 4 * q; const f32x4 lo = *(const LAS f32x4*)s, hi = *(const LAS f32x4*)(s + 16);
          u32x4 o; o.x = pk2(lo.x, lo.y); o.y = pk2(lo.z, lo.w); o.z = pk2(hi.x, hi.y); o.w = pk2(hi.z, hi.w);
          *(u32x4*)(dp1 + (size_t)f * 8) = o; }
    }
    LDS_BARRIER();
}

__device__ __forceinline__ void delta_scan(const Params& p, int item) {
    const int lane = fresh_tid() & 63, fr = lane & 15, fq = lane >> 4;
    const int bh = item >> 3, sl = item & 7, h = bh & 3, b = bh >> 2;
    unsigned char* ws = p.ws;
    float* od = (float*)(ws + O_ODELTA);
    f32x4 S[8];
#pragma unroll
    for (int i = 0; i < 8; ++i) S[i] = (f32x4){0.f, 0.f, 0.f, 0.f};
#pragma unroll 1
    for (int c = 0; c < 32; ++c) {
        const int chunk = bh * 32 + c;
        const bf16x8* wf = (const bf16x8*)(ws + O_DP1 + (size_t)chunk * 32768) + lane;
        const bf16_t* uu = (const bf16_t*)(ws + O_DP1 + (size_t)chunk * 32768 + 16384);
        const bf16x8* qg = (const bf16x8*)(ws + O_DP2 + (size_t)chunk * 40960) + lane;
        const bf16x8* kd = qg + 1024; const bf16x8* qk = qg + 2048;
        const float gl = ((const float*)(ws + O_GL))[chunk];
        bf16x8 bS[4];
#pragma unroll
        for (int ks = 0; ks < 4; ++ks) { u32x4 w; w.x = pk2(S[2 * ks].x, S[2 * ks].y); w.y = pk2(S[2 * ks].z, S[2 * ks].w); w.z = pk2(S[2 * ks + 1].x, S[2 * ks + 1].y); w.w = pk2(S[2 * ks + 1].z, S[2 * ks + 1].w); bS[ks] = __builtin_bit_cast(bf16x8, w); }
        f32x4 vn[4], o[4];
#pragma unroll
        for (int mt = 0; mt < 4; ++mt) {
            f32x4 a = (f32x4){0.f, 0.f, 0.f, 0.f}, q = a;
#pragma unroll
            for (int ks = 0; ks < 4; ++ks) { a = __builtin_amdgcn_mfma_f32_16x16x32_bf16(wf[(mt * 4 + ks) * 64], bS[ks], a, 0, 0, 0); q = __builtin_amdgcn_mfma_f32_16x16x32_bf16(qg[(mt * 4 + ks) * 64], bS[ks], q, 0, 0, 0); }
            f32x4 uv;
#pragma unroll
            for (int r = 0; r < 4; ++r) uv[r] = bf1(uu[(16 * mt + 4 * fq + r) * 128 + 16 * sl + fr]);
            vn[mt] = uv - a; o[mt] = q;
        }
        __builtin_amdgcn_sched_barrier(0);
        bf16x8 bV[2];
#pragma unroll
        for (int ks = 0; ks < 2; ++ks) { u32x4 w; w.x = pk2(vn[2 * ks].x, vn[2 * ks].y); w.y = pk2(vn[2 * ks].z, vn[2 * ks].w); w.z = pk2(vn[2 * ks + 1].x, vn[2 * ks + 1].y); w.w = pk2(vn[2 * ks + 1].z, vn[2 * ks + 1].w); bV[ks] = __builtin_bit_cast(bf16x8, w); }
#pragma unroll
        for (int mt = 0; mt < 4; ++mt) {
#pragma unroll
            for (int ks = 0; ks < 2; ++ks) o[mt] = __builtin_amdgcn_mfma_f32_16x16x32_bf16(qk[(mt * 2 + ks) * 64], bV[ks], o[mt], 0, 0, 0);
            const int rowb = b * SEQ + c * 64 + 16 * mt + 4 * fq;
#pragma unroll
            for (int r = 0; r < 4; ++r) od[(size_t)(rowb + r) * 512 + h * 128 + 16 * sl + fr] = o[mt][r];
        }
        __builtin_amdgcn_sched_barrier(0);
#pragma unroll
        for (int m8 = 0; m8 < 8; ++m8) {
            f32x4 s = S[m8] * gl;
#pragma unroll
            for (int ks = 0; ks < 2; ++ks) s = __builtin_amdgcn_mfma_f32_16x16x32_bf16(kd[(m8 * 2 + ks) * 64], bV[ks], s, 0, 0, 0);
            S[m8] = s;
        }
    }
}

struct S5C { float lbr, lbi; float bbr[16], bbi[16]; };
__device__ __forceinline__ void s5_consts(const Params& p, int g, int lane, float& lbr, float& lbi, float (&bbr)[16], float (&bbi)[16]) {
    const float dt = expf(p.in[19][g]); const float lr = p.in[12][g * 64 + lane], li = p.in[13][g * 64 + lane];
    const float mag = expf(lr * dt); float sn, cs; sincosf(li * dt, &sn, &cs); lbr = mag * cs; lbi = mag * sn;
    const float den = lr * lr + li * li, nr = lbr - 1.0f, ni = lbi; const float cr = (nr * lr + ni * li) / den, ci = (ni * lr - nr * li) / den;
    const f32x4* br4 = (const f32x4*)(p.in[14] + (size_t)(g * 64 + lane) * 16); const f32x4* bi4 = (const f32x4*)(p.in[15] + (size_t)(g * 64 + lane) * 16);
#pragma unroll
    for (int q = 0; q < 4; ++q) { const f32x4 br = br4[q], bi = bi4[q];
#pragma unroll
        for (int k = 0; k < 4; ++k) { bbr[4 * q + k] = cr * br[k] - ci * bi[k]; bbi[4 * q + k] = cr * bi[k] + ci * br[k]; } }
}
#define S5_STEP(t) do { float bur = 0.f, bui = 0.f; \
    _Pragma("unroll") for (int k = 0; k < 8; ++k) { const unsigned w = (unsigned)__builtin_amdgcn_readlane((int)ur[k], (t)); const float u0 = bflo(w), u1 = bfhi(w); \
        bur += bbr[2 * k] * u0; bui += bbi[2 * k] * u0; bur += bbr[2 * k + 1] * u1; bui += bbi[2 * k + 1] * u1; } \
    const float nxr = lbr * xr - lbi * xi + bur, nxi = lbr * xi + lbi * xr + bui; xr = nxr; xi = nxi; } while (0)

__device__ __forceinline__ void s5_pass1(const Params& p, int unit) {
    const int lane = fresh_tid() & 63; const int c = unit & 31, g = (unit >> 5) & 31, b = unit >> 10;
    float lbr, lbi, bbr[16], bbi[16]; s5_consts(p, g, lane, lbr, lbi, bbr, bbi);
    const bf16_t* up = (const bf16_t*)(p.ws + O_U) + (size_t)(b * SEQ + c * 64 + lane) * 512 + g * 16;
    unsigned ur[8]; { const u32x4 a = *(const u32x4*)up, bq = *(const u32x4*)(up + 8); ur[0] = a.x; ur[1] = a.y; ur[2] = a.z; ur[3] = a.w; ur[4] = bq.x; ur[5] = bq.y; ur[6] = bq.z; ur[7] = bq.w; }
    float xr = 0.f, xi = 0.f;
#pragma unroll 4
    for (int t = 0; t < 64; ++t) S5_STEP(t);
    float* xe = (float*)(p.ws + O_XEND) + ((size_t)unit * 64 + lane) * 2; xe[0] = xr; xe[1] = xi;
}
__device__ __forceinline__ void s5_combine(const Params& p, int idx) {
    const int pp = idx & 63, g = (idx >> 6) & 31, b = idx >> 11;
    const float dt = expf(p.in[19][g]); const float lr = p.in[12][g * 64 + pp], li = p.in[13][g * 64 + pp];
    const float mag = expf(lr * dt); float sn, cs; sincosf(li * dt, &sn, &cs); float ar = mag * cs, ai = mag * sn;
#pragma unroll
    for (int k = 0; k < 6; ++k) { const float nr = ar * ar - ai * ai, ni = 2.0f * ar * ai; ar = nr; ai = ni; }
    float xr = 0.f, xi = 0.f;
    const float* xe = (const float*)(p.ws + O_XEND); float* xp = (float*)(p.ws + O_XPREV);
    for (int c = 0; c < 32; ++c) { const size_t o = (((size_t)(b * 32 + g) * 32 + c) * 64 + pp) * 2;
        xp[o] = xr; xp[o + 1] = xi; const float er = xe[o], ei = xe[o + 1];
        const float nr = ar * xr - ai * xi + er, ni = ar * xi + ai * xr + ei; xr = nr; xi = ni; }
}
__device__ __forceinline__ void s5_pass2(const Params& p, LAS unsigned char* lds, int unit) {
    const int tid2 = fresh_tid(); const int lane = tid2 & 63, wave = tid2 >> 6, fr = lane & 15, fq = lane >> 4;
    const int c = unit & 31, g = (unit >> 5) & 31, b = unit >> 10;
    LAS float* XS = (LAS float*)(lds + wave * 8448);
    float lbr, lbi, bbr[16], bbi[16]; s5_consts(p, g, lane, lbr, lbi, bbr, bbi);
    const int rowb = b * SEQ + c * 64;
    const bf16_t* ub = (const bf16_t*)(p.ws + O_U);
    const bf16_t* up = ub + (size_t)(rowb + lane) * 512 + g * 16;
    unsigned ur[8]; { const u32x4 a = *(const u32x4*)up, bq = *(const u32x4*)(up + 8); ur[0] = a.x; ur[1] = a.y; ur[2] = a.z; ur[3] = a.w; ur[4] = bq.x; ur[5] = bq.y; ur[6] = bq.z; ur[7] = bq.w; }
    float cc[32];
#pragma unroll
    for (int ks = 0; ks < 32; ++ks) { const int k = 4 * ks + fq; cc[ks] = ks < 16 ? p.in[16][(size_t)(g * 16 + fr) * 64 + k] : -p.in[17][(size_t)(g * 16 + fr) * 64 + (k - 64)]; }
    const f32x4 dd = *(const f32x4*)(p.in[18] + g * 16 + 4 * fq);
    const float* xp = (const float*)(p.ws + O_XPREV) + ((size_t)unit * 64 + lane) * 2;
    float xr = xp[0], xi = xp[1];
    bf16_t* yg = (bf16_t*)(p.ws + O_YG);
#pragma unroll 1
    for (int sc = 0; sc < 4; ++sc) {
#pragma unroll 4
        for (int t16 = 0; t16 < 16; ++t16) { S5_STEP(sc * 16 + t16); XS[t16 * 130 + lane] = xr; XS[t16 * 130 + 64 + lane] = xi; }
        asm volatile("s_waitcnt lgkmcnt(0)" ::: "memory");
        f32x4 acc = (f32x4){0.f, 0.f, 0.f, 0.f};
#pragma unroll
        for (int ks = 0; ks < 32; ++ks) acc = __builtin_amdgcn_mfma_f32_16x16x4f32(cc[ks], XS[fr * 130 + 4 * ks + fq], acc, 0, 0, 0);
        const int row = rowb + sc * 16 + fr;
        const u32x2 uw = *(const u32x2*)(ub + (size_t)row * 512 + g * 16 + 4 * fq);
        f32x4 y; y.x = acc[0] + dd.x * bflo(uw.x); y.y = acc[1] + dd.y * bfhi(uw.x); y.z = acc[2] + dd.z * bflo(uw.y); y.w = acc[3] + dd.w * bfhi(uw.y);
        y.x = gelu_tanh(y.x); y.y = gelu_tanh(y.y); y.z = gelu_tanh(y.z); y.w = gelu_tanh(y.w);
        pg8::st_bf4(yg + (size_t)row * 512 + g * 16 + 4 * fq, y);
        asm volatile("s_waitcnt lgkmcnt(0)" ::: "memory");
    }
}

template <int ONLYT> __global__ void __launch_bounds__(512) fwd_kernel(Params p) {
    extern __shared__ __attribute__((aligned(16))) unsigned char lds_raw[];
    LAS unsigned char* lds = (LAS unsigned char*)lds_raw;
    cg::grid_group grid = cg::this_grid();
    const int G = gridDim.x, bx = blockIdx.x;
    unsigned char* ws = p.ws;
    float* SSQ = (float*)(ws + O_SSQ);
    float* X = p.out; bf16_t* XB = (bf16_t*)(ws + O_XB);

    if (PH(0)) phase_prologue(p, lds, G);
    if (ONLYT < 0) grid.sync();

    if (PH(1)) {
        pg8::SchedPlain S{(const char*)XB, (const char*)(ws + O_WIN), 1024, 1024, 64, 11, G, bx, 0, 256};
        pg8::EpiWin E{SSQ, (bf16_t*)(ws + O_QKVRAW), (bf16_t*)(ws + O_GATE), (float*)(ws + O_BA), (bf16_t*)(ws + O_U)};
        pg8::gemm_phase(lds, 1024, 1024, 1024, S, E);
        pg8::SchedKV S2{(const char*)(ws + O_MEMN), (const char*)(ws + O_WKV), G, (bx + 64) % G};
        pg8::EpiKV E2{(bf16_t*)(ws + O_KM), (bf16_t*)(ws + O_VT)};
        pg8::gemm_phase(lds, 1024, 1024, 1024, S2, E2);
    }
    if (ONLYT < 0) grid.sync();

    if (PH(2)) for (int ch = bx; ch < 1024; ch += G) delta_prep(p, lds, ch);
    if (PH(3)) for (int un = bx * 8 + (fresh_tid() >> 6); un < 8192; un += G * 8) s5_pass1(p, un);
    if (ONLYT < 0) grid.sync();

    if (PH(4)) for (int i = bx * 512 + fresh_tid(); i < 16384; i += G * 512) s5_combine(p, i);
    if (ONLYT < 0) grid.sync();

    { const int wave = fresh_tid() >> 6;
    if (wave == 0) { if (PH(5)) for (int it = bx; it < 256; it += G) delta_scan(p, it); }
    else { if (PH(6)) for (int un = bx * 7 + (wave - 1); un < 8192; un += G * 7) s5_pass2(p, lds, un); } }
    if (ONLYT < 0) grid.sync();

    if (PH(7)) {
        const int tid = fresh_tid(), lane = tid & 63, wave = tid >> 6;
        const float* od = (const float*)(ws + O_ODELTA); const bf16_t* gt = (const bf16_t*)(ws + O_GATE); bf16_t* mx = (bf16_t*)(ws + O_MIXED);
        const f32x4* og = (const f32x4*)(p.in[11] + (lane & 15) * 8);
        const f32x4 g0 = og[0], g1 = og[1];
        for (int r = bx * 8 + wave; r < MT; r += G * 8) {
            const f32x4* op = (const f32x4*)(od + (size_t)r * 512 + lane * 8); const f32x4 a = op[0], bq = op[1];
            float s = (a.x * a.x + a.y * a.y) + (a.z * a.z + a.w * a.w) + (bq.x * bq.x + bq.y * bq.y) + (bq.z * bq.z + bq.w * bq.w);
            s += __shfl_xor(s, 1); s += __shfl_xor(s, 2); s += __shfl_xor(s, 4); s += __shfl_xor(s, 8);
            const float rs = rsqrtf(s * (1.0f / 128.0f) + EPS);
            const u32x4 gw = *(const u32x4*)(gt + (size_t)r * 512 + lane * 8);
            u32x4 o;
            o.x = pk2(a.x * rs * g0.x * silu_f(bflo(gw.x)), a.y * rs * g0.y * silu_f(bfhi(gw.x)));
            o.y = pk2(a.z * rs * g0.z * silu_f(bflo(gw.y)), a.w * rs * g0.w * silu_f(bfhi(gw.y)));
            o.z = pk2(bq.x * rs * g1.x * silu_f(bflo(gw.z)), bq.y * rs * g1.y * silu_f(bfhi(gw.z)));
            o.w = pk2(bq.z * rs * g1.z * silu_f(bflo(gw.w)), bq.w * rs * g1.w * silu_f(bfhi(gw.w)));
            *(u32x4*)(mx + (size_t)r * 1024 + lane * 8) = o;
        }
    }
    if (PH(8)) {
        pg8::SchedPlain S{(const char*)(ws + O_YG), (const char*)(ws + O_WGLU), 512, 512, 64, 2, G, bx, 0, 256};
        pg8::EpiGlu E{(const bf16_t*)(ws + O_YG), p.in[21], (bf16_t*)(ws + O_MIXED)};
        pg8::gemm_phase(lds, 512, 512, 512, S, E);
    }
    if (ONLYT < 0) grid.sync();

    if (PH(9)) {
        pg8::SchedPlain S{(const char*)(ws + O_MIXED), (const char*)(ws + O_WOUT), 1024, 1024, 64, 4, G, bx, 0, 256};
        pg8::EpiRes E{X, XB, SSQ + 1 * MT, nullptr};
        pg8::gemm_phase(lds, 1024, 1024, 1024, S, E);
    }
    if (ONLYT < 0) grid.sync();

#pragma unroll 1
    for (int layer = p.l_lo; layer < p.l_hi; ++layer) {
        if (layer == 1) {
          if (PH(10)) {
            const int tid = fresh_tid();
            const float* ssq = SSQ + 3 * MT; const float* gm = p.in[2] + 1024; bf16_t* dp = (bf16_t*)(ws + O_DPOOL);
            for (int seg = bx; seg < 256; seg += G) {
                const int q = tid & 255, hh = tid >> 8, col = 4 * q, w = 2 << (q >> 6);
                const int r0 = seg * 64 + hh * 32; const f32x4 gg = *(const f32x4*)(gm + col);
                f32x4 s = (f32x4){0.f, 0.f, 0.f, 0.f};
                for (int k = w - 1; k >= 1; --k) { const int r = r0 - k; if ((r0 & 2047) - k >= 0) { const float rs = rsqrtf(ssq[r] * (1.0f / 1024.0f) + EPS); s = s + *(const f32x4*)(X + (size_t)r * 1024 + col) * rs * gg; } }
                for (int i = 0; i < 32; ++i) { const int r = r0 + i, ts = r & 2047;
                    const float rs = rsqrtf(ssq[r] * (1.0f / 1024.0f) + EPS); const f32x4 xn = *(const f32x4*)(X + (size_t)r * 1024 + col) * rs * gg;
                    s = s + xn; const float inv = 1.0f / (float)(ts + 1 < w ? ts + 1 : w);
                    pg8::st_bf4(dp + (size_t)r * 1024 + col, s * inv - xn);
                    if (ts - w + 1 >= 0) { const int rl = r - w + 1; const float rl_s = rsqrtf(ssq[rl] * (1.0f / 1024.0f) + EPS); s = s - *(const f32x4*)(X + (size_t)rl * 1024 + col) * rl_s * gg; } }
            }
          }
            if (ONLYT < 0) grid.sync();
            if (PH(19)) {
                pg8::SchedPlain S{(const char*)(ws + O_DPOOL), (const char*)(ws + O_POOL), 1024, 256, 64, 4, G, bx, 256, 256};
                pg8::EpiRes E{X, XB, SSQ + 4 * MT, p.in[24]};
                pg8::gemm_phase(lds, 1024, 256, 256, S, E);
            }
            if (ONLYT < 0) grid.sync();
        }
        const int sx = layer == 0 ? 1 : 4;
        if (PH(11)) {
            pg8::SchedPlain S{(const char*)XB, (const char*)(ws + O_WQ + (size_t)layer * 2097152), 1024, 1024, 64, 4, G, bx, 0, 256};
            pg8::EpiScaleBf E{SSQ + sx * MT, (bf16_t*)(ws + O_Q), 1024, 0.0625f};
            pg8::gemm_phase(lds, 1024, 1024, 1024, S, E);
        }
        if (ONLYT < 0) grid.sync();
        if (PH(12)) {
            pg8::SchedAttn S{(const char*)(ws + O_Q), (const char*)(ws + O_KM + (size_t)layer * 4194304), 0, G, bx};
            pg8::EpiSoftmax E{(bf16_t*)(ws + O_P)};
            pg8::gemm_phase(lds, 1024, 1024, 256, S, E);
        }
        if (ONLYT < 0) grid.sync();
        if (PH(13)) {
            pg8::SchedAttn S{(const char*)(ws + O_P), (const char*)(ws + O_VT + (size_t)layer * 4194304), 1, G, bx};
            pg8::EpiScaleBf E{nullptr, (bf16_t*)(ws + O_O), 1024, 1.0f};
            pg8::gemm_phase(lds, 1024, 256, 256, S, E);
        }
        if (ONLYT < 0) grid.sync();
        if (PH(14)) {
            pg8::SchedPlain S{(const char*)(ws + O_O), (const char*)(ws + O_WO + (size_t)layer * 2097152), 1024, 1024, 64, 4, G, bx, 0, 256};
            pg8::EpiRes E{X, XB, SSQ + (sx + 1) * MT, nullptr};
            pg8::gemm_phase(lds, 1024, 1024, 1024, S, E);
        }
        if (ONLYT < 0) grid.sync();
        if (PH(15)) {
            pg8::SchedPlain S{(const char*)XB, (const char*)(ws + O_WUP + (size_t)layer * 11534336), 1024, 1024, 64, 22, G, bx, 0, 256};
            pg8::EpiUp E{SSQ + (sx + 1) * MT, p.in[29] + (size_t)layer * 3 * FF2, (bf16_t*)(ws + O_ACT), (float*)(ws + O_HALO)};
            pg8::gemm_phase(lds, 1024, 1024, 1024, S, E);
        }
        if (ONLYT < 0) grid.sync();
        if (PH(16)) {
            const int tid = fresh_tid();
            const float* hl = (const float*)(ws + O_HALO); const float* cw = p.in[29] + (size_t)layer * 3 * FF2; bf16_t* act = (bf16_t*)(ws + O_ACT);
            for (int i = bx * 512 + tid; i < 64 * FF; i += G * 512) {
                const int pm = i / FF, ch = i - pm * FF; if ((pm & 7) == 0) continue;
                const int pg = (ch >> 7) * 256 + (ch & 127), pv = pg + 128;
                const float* hp = hl + (size_t)(pm - 1) * 4 * FF2; const float* hc = hl + (size_t)pm * 4 * FF2;
                const float gm2 = hp[2 * FF2 + pg], gm1 = hp[3 * FF2 + pg], g0 = hc[pg], g1 = hc[FF2 + pg];
                const float vm2 = hp[2 * FF2 + pv], vm1 = hp[3 * FF2 + pv], v0 = hc[pv], v1 = hc[FF2 + pv];
                const float a0 = cw[ch], a1 = cw[FF2 + ch], a2 = cw[2 * FF2 + ch], b0 = cw[FF + ch], b1 = cw[FF2 + FF + ch], b2 = cw[2 * FF2 + FF + ch];
                const float o0 = silu_f(a2 * g0 + a1 * gm1 + a0 * gm2) * (b2 * v0 + b1 * vm1 + b0 * vm2);
                const float o1 = silu_f(a2 * g1 + a1 * g0 + a0 * gm1) * (b2 * v1 + b1 * v0 + b0 * vm1);
                act[(size_t)(pm * 256) * FF + ch] = (bf16_t)f2bf(o0); act[(size_t)(pm * 256 + 1) * FF + ch] = (bf16_t)f2bf(o1);
            }
        }
        if (ONLYT < 0) grid.sync();
        if (PH(17)) {
            pg8::SchedPlain S{(const char*)(ws + O_ACT), (const char*)(ws + O_WDN + (size_t)layer * 5767168), FF, FF, 64, 4, G, bx, 0, 256};
            pg8::EpiRes E{X, XB, SSQ + (sx + 2) * MT, nullptr};
            pg8::gemm_phase(lds, FF, FF, FF, S, E);
        }
        if (ONLYT < 0) grid.sync();
    }
    if (PH(18)) {
        const int tid = fresh_tid(), lane = tid & 63, wave = tid >> 6;
        const float* ssq = SSQ + 6 * MT; const f32x4* gf = (const f32x4*)p.in[6] + lane;
        for (int r = bx * 8 + wave; r < MT; r += G * 8) {
            const float rs = rsqrtf(ssq[r] * (1.0f / 1024.0f) + EPS); f32x4* xp = (f32x4*)(X + (size_t)r * 1024) + lane;
#pragma unroll
            for (int j = 0; j < 4; ++j) xp[64 * j] = xp[64 * j] * rs * gf[64 * j];
        }
    }
}

#ifndef MULTI_LAUNCH
#define MULTI_LAUNCH 0
#endif
template <int K> static void launch_phase(const Params& p, int lo, int hi, int grid, hipStream_t stream) {
    static bool attr = false;
    if (!attr) { (void)hipFuncSetAttribute((const void*)fwd_kernel<K>, hipFuncAttributeMaxDynamicSharedMemorySize, LDS_BYTES); attr = true; }
    Params q = p; q.l_lo = lo; q.l_hi = hi;
    hipLaunchKernelGGL(fwd_kernel<K>, dim3(grid), dim3(512), LDS_BYTES, stream, q);
}
extern "C" void kernel_launch(void* const* d_in, const int* in_sizes, int n_in, void* d_out, int out_size, void* d_ws, size_t ws_size, hipStream_t stream) {
    Params p{};
    for (int i = 0; i < 31; ++i) p.in[i] = (const float*)d_in[i];
    p.out = (float*)d_out; p.ws = (unsigned char*)d_ws; p.l_lo = 0; p.l_hi = 2;
#if MULTI_LAUNCH
    const int g = 256;
    launch_phase<0>(p, 0, 0, g, stream); launch_phase<1>(p, 0, 0, g, stream); launch_phase<2>(p, 0, 0, g, stream); launch_phase<3>(p, 0, 0, g, stream);
    launch_phase<4>(p, 0, 0, g, stream); launch_phase<5>(p, 0, 0, g, stream); launch_phase<6>(p, 0, 0, g, stream); launch_phase<7>(p, 0, 0, g, stream);
    launch_phase<8>(p, 0, 0, g, stream); launch_phase<9>(p, 0, 0, g, stream);
    for (int l = 0; l < 2; ++l) {
        if (l == 1) { launch_phase<10>(p, 1, 2, g, stream); launch_phase<19>(p, 1, 2, g, stream); }
        launch_phase<11>(p, l, l + 1, g, stream); launch_phase<12>(p, l, l + 1, g, stream); launch_phase<13>(p, l, l + 1, g, stream); launch_phase<14>(p, l, l + 1, g, stream);
        launch_phase<15>(p, l, l + 1, g, stream); launch_phase<16>(p, l, l + 1, g, stream); launch_phase<17>(p, l, l + 1, g, stream);
    }
    launch_phase<18>(p, 0, 0, g, stream);
#else
    static int grid_blocks = 0;
    if (!grid_blocks) {
        int dev = 0, cus = 0, per_cu = 0;
        (void)hipGetDevice(&dev);
        (void)hipDeviceGetAttribute(&cus, hipDeviceAttributeMultiprocessorCount, dev);
        (void)hipFuncSetAttribute((const void*)fwd_kernel<-1>, hipFuncAttributeMaxDynamicSharedMemorySize, LDS_BYTES);
        (void)hipOccupancyMaxActiveBlocksPerMultiprocessor(&per_cu, (const void*)fwd_kernel<-1>, 512, LDS_BYTES);
        if (per_cu < 1) { fprintf(stderr, "occupancy query returned %d\n", per_cu); per_cu = 1; }
        grid_blocks = cus * per_cu;
        if (grid_blocks > 256) grid_blocks = 256;
    }
    void* args[] = {&p};
    hipError_t e = hipLaunchCooperativeKernel((const void*)fwd_kernel<-1>, dim3(grid_blocks), dim3(512), args, LDS_BYTES, stream);
    if (e != hipSuccess) fprintf(stderr, "cooperative launch failed: %s (grid %d)\n", hipGetErrorString(e), grid_blocks);
#endif
}
```

```cpp
#include <hip/hip_runtime.h>
#include <hip/hip_cooperative_groups.h>
#include <cstdio>
#include <cstdint>
namespace cg = cooperative_groups;

#define LAS __attribute__((address_space(3)))
typedef unsigned short bf16_t;
typedef short bf16x8 __attribute__((ext_vector_type(8)));
typedef float f32x4 __attribute__((ext_vector_type(4)));
typedef unsigned u32x4 __attribute__((ext_vector_type(4)));
typedef unsigned u32x2 __attribute__((ext_vector_type(2)));

constexpr int MT = 16384, DM = 1024, SEQ = 2048, NBATCH = 8;
constexpr int NIN = 2568, FF = 2816, FF2 = 5632;
constexpr float EPS = 1e-6f;
constexpr size_t HM = 524288;
constexpr size_t O_SSQ = 0;
constexpr size_t O_GL = 480 * 1024;
constexpr size_t O_WIN = 2 * HM;
constexpr size_t O_WGLU = 13 * HM;
constexpr size_t O_WOUT = 14 * HM;
constexpr size_t O_WQ = 18 * HM;
constexpr size_t O_WKV = 26 * HM;
constexpr size_t O_WO = 42 * HM;
constexpr size_t O_WUP = 50 * HM;
constexpr size_t O_WDN = 94 * HM;
constexpr size_t O_POOL = 116 * HM;
constexpr size_t O_MEMN = 117 * HM;
constexpr size_t O_KM = 125 * HM;
constexpr size_t O_VT = 141 * HM;
constexpr size_t O_XEND = 157 * HM;
constexpr size_t O_XPREV = 165 * HM;
constexpr size_t O_BA = 173 * HM;
constexpr size_t O_HALO = 174 * HM;
constexpr size_t O_XB = 186 * HM;
constexpr size_t O_R = 250 * HM;
constexpr size_t O_QKVRAW = O_R;
constexpr size_t O_GATE = O_R + 96 * HM;
constexpr size_t O_U = O_R + 128 * HM;
constexpr size_t O_DP2 = O_R + 160 * HM;
constexpr size_t O_DP1 = O_XB;
constexpr size_t O_ODELTA = O_R;
constexpr size_t O_YG = O_R + 64 * HM;
constexpr size_t O_MIXED = O_R + 160 * HM;
constexpr size_t O_Q = O_R;
constexpr size_t O_P = O_R + 64 * HM;
constexpr size_t O_O = O_R;
constexpr size_t O_ACT = O_R;
constexpr size_t O_DPOOL = O_R;
constexpr int LDS_BYTES = 147456;
constexpr int LDS_SCR = 131072;

struct Params { const float* in[31]; float* out; unsigned char* ws; int l_lo, l_hi; };
#define PH(k) (ONLYT < 0 || ONLYT == (k))

__device__ __forceinline__ unsigned f2bf(float f) { unsigned u = __float_as_uint(f); return (u + 0x7fffu + ((u >> 16) & 1u)) >> 16; }
__device__ __forceinline__ unsigned pk2(float lo, float hi) { return f2bf(lo) | (f2bf(hi) << 16); }
__device__ __forceinline__ float bflo(unsigned w) { return __uint_as_float(w << 16); }
__device__ __forceinline__ float bfhi(unsigned w) { return __uint_as_float(w & 0xffff0000u); }
__device__ __forceinline__ float bf1(bf16_t h) { return __uint_as_float(((unsigned)h) << 16); }
__device__ __forceinline__ float wave_sum(float v) {
#pragma unroll
    for (int o = 1; o < 64; o <<= 1) v += __shfl_xor(v, o);
    return v;
}
__device__ __forceinline__ int fresh_tid() { int t = threadIdx.x; asm volatile("" : "+v"(t)); return t; }
__device__ __forceinline__ float silu_f(float x) { return x * __builtin_amdgcn_rcpf(1.0f + __expf(-x)); }
__device__ __forceinline__ float sigmoid_f(float x) { return __builtin_amdgcn_rcpf(1.0f + __expf(-x)); }
__device__ __forceinline__ float gelu_tanh(float v) {
    const float z = 0.7978845608f * (v + 0.044715f * v * v * v);
    const float e = __expf(2.0f * z);
    const float th = 1.0f - 2.0f * __builtin_amdgcn_rcpf(e + 1.0f);
    return 0.5f * v * (1.0f + th);
}
template <int CTRL> __device__ __forceinline__ float dppf(float x) { return __int_as_float(__builtin_amdgcn_update_dpp(0, __float_as_int(x), CTRL, 0xf, 0xf, false)); }
template <int CTRL> __device__ __forceinline__ f32x4 dpp4(f32x4 x) { f32x4 r; r.x = dppf<CTRL>(x.x); r.y = dppf<CTRL>(x.y); r.z = dppf<CTRL>(x.z); r.w = dppf<CTRL>(x.w); return r; }
#define WG_BARRIER() do { asm volatile("s_waitcnt vmcnt(0) lgkmcnt(0)" ::: "memory"); __builtin_amdgcn_s_barrier(); asm volatile("" ::: "memory"); } while (0)
#define LDS_BARRIER() do { asm volatile("s_waitcnt lgkmcnt(0)" ::: "memory"); __builtin_amdgcn_s_barrier(); asm volatile("" ::: "memory"); } while (0)

namespace pg8 {
constexpr int BM = 256, BK = 64, HALF = 128, HTB = HALF * BK * 2;
__device__ __forceinline__ int lds_byte(int r, int c) { const int st = (r >> 4) * 2 + (c >> 5), rr = r & 15, cc = c & 31, ob = rr * 64 + cc * 2; return st * 1024 + (ob ^ (((ob >> 9) & 1) << 5)); }
__device__ __forceinline__ void stage_rc(int b, int& R, int& C) { const int st = b / 1024, sb = b % 1024, swz = sb ^ (((sb >> 9) & 1) << 5); R = (st >> 1) * 16 + swz / 64; C = (st & 1) * 32 + (swz % 64) / 2; }

struct Unit { const char* A; const char* B; int row0, col0, aux; };

__device__ __forceinline__ bool tile_order(int i, int G, int c, int nM, int nN, int& pm, int& pn) {
    const int nwg = nM * nN; const long L = (long)i * G + c; if (L >= nwg) return false;
    int wgid = (int)L; { const int q = nwg / 8, r = nwg % 8, xcd = wgid % 8, off = wgid / 8; wgid = (xcd < r ? xcd * (q + 1) : r * (q + 1) + (xcd - r) * q) + off; }
    const int nig = 8 * nN, gid = wgid / nig, fm = gid * 8, gsz = (nM - fm) < 8 ? (nM - fm) : 8;
    pm = fm + ((wgid % nig) % gsz); pn = (wgid % nig) / gsz; return true;
}

template <class Epi, class Sched>
__device__ __forceinline__ void gemm_phase(LAS unsigned char* lds, const int lda, const int ldb, const int K, const Sched& S, const Epi& E) {
    int tid_ = threadIdx.x; asm volatile("" : "+v"(tid_));
    const int tid = tid_, wid = __builtin_amdgcn_readfirstlane(tid >> 6), lane = tid & 63, wr = wid >> 2, wc = wid & 3, fr = lane & 15, fq = lane >> 4;
    const int nt = K / BK;
    unsigned voffA[2], voffB[2];
#pragma unroll
    for (int i = 0; i < 2; ++i) { int R, C; stage_rc(tid * 16 + i * 8192, R, C); voffA[i] = (unsigned)(R * lda + C) * 2u; voffB[i] = (unsigned)(R * ldb + C) * 2u; }
    const size_t kstep = (size_t)(BK * 2);
    const size_t hstepA = (size_t)HALF * lda * 2, hstepB = (size_t)HALF * ldb * 2;
    const unsigned ldsw = (unsigned)wid * 1024u;
    const int aoff = lds_byte(wr * 64 + fr, fq * 8), boff = lds_byte(wc * 32 + fr, fq * 8);
#define PG8_SA(b, h) (((b) * 2 + (h)) * HTB)
#define PG8_SB(b, h) ((4 + (b) * 2 + (h)) * HTB)
#define PG8_STAGE(bufoff, gbase, voff) do { _Pragma("unroll") for (int _i = 0; _i < 2; ++_i) \
        __builtin_amdgcn_global_load_lds((const unsigned*)((const char*)(gbase) + (voff)[_i]), (LAS unsigned*)(lds + (bufoff) + ldsw + _i * 8192), 16, 0, 0); } while (0)
#define PG8_LDA(dst, b, h) do { _Pragma("unroll") for (int m = 0; m < 4; ++m) _Pragma("unroll") for (int k = 0; k < 2; ++k) dst[m][k] = *(const LAS bf16x8*)(lds + PG8_SA(b, h) + aoff + m * 2048 + k * 1024); } while (0)
#define PG8_LDB(dst, b, h) do { _Pragma("unroll") for (int n = 0; n < 2; ++n) _Pragma("unroll") for (int k = 0; k < 2; ++k) dst[n][k] = *(const LAS bf16x8*)(lds + PG8_SB(b, h) + boff + n * 2048 + k * 1024); } while (0)
#define PG8_MMA(ai, bj, At, Bt) do { __builtin_amdgcn_s_setprio(1); _Pragma("unroll") for (int m = 0; m < 4; ++m) _Pragma("unroll") for (int n = 0; n < 2; ++n) _Pragma("unroll") for (int k = 0; k < 2; ++k) \
        acc[ai][bj][m][n] = __builtin_amdgcn_mfma_f32_16x16x32_bf16(Bt[n][k], At[m][k], acc[ai][bj][m][n], 0, 0, 0); __builtin_amdgcn_s_setprio(0); } while (0)
#define PG8_WAIT_V(n) asm volatile("s_waitcnt vmcnt(" #n ")" ::: "memory")
#define PG8_WAIT_L(n) asm volatile("s_waitcnt lgkmcnt(" #n ")" ::: "memory")
#define PG8_BAR __builtin_amdgcn_s_barrier()
#define PG8_SCHED __builtin_amdgcn_sched_barrier(0)
    Unit cur, nxt; int ui = 0;
    if (!S.next(0, cur)) return;
    f32x4 acc[2][2][4][2];
#pragma unroll
    for (int a = 0; a < 2; ++a)
#pragma unroll
        for (int b = 0; b < 2; ++b)
#pragma unroll
            for (int m = 0; m < 4; ++m)
#pragma unroll
                for (int n = 0; n < 2; ++n) acc[a][b][m][n] = (f32x4){0.f, 0.f, 0.f, 0.f};
    bf16x8 At[4][2], B0[2][2], B1[2][2];
    const char* cA = cur.A; const char* cB = cur.B;
    PG8_STAGE(PG8_SB(0, 0), cB, voffB); PG8_STAGE(PG8_SB(0, 1), cB + hstepB, voffB); PG8_STAGE(PG8_SA(0, 0), cA, voffA); PG8_STAGE(PG8_SA(0, 1), cA + hstepA, voffA);
    if (wr == 1) PG8_BAR;
    PG8_WAIT_V(2); PG8_BAR;
    PG8_STAGE(PG8_SB(1, 0), cB + kstep, voffB); PG8_STAGE(PG8_SA(1, 0), cA + kstep, voffA); PG8_STAGE(PG8_SB(1, 1), cB + hstepB + kstep, voffB);
    PG8_WAIT_V(6); PG8_BAR;
    for (;;) {
        const bool has_next = S.next(ui + 1, nxt);
        const char* nA = has_next ? nxt.A : cA; const char* nB = has_next ? nxt.B : cB;
#pragma unroll 1
        for (int t = 0; t < nt; t += 2) {
            const bool last = (t == nt - 2);
            const char* a1 = cA + (size_t)(t + 1) * kstep;
            const char* a2 = last ? nA : cA + (size_t)(t + 2) * kstep; const char* b2 = last ? nB : cB + (size_t)(t + 2) * kstep;
            const char* a3 = a2 + kstep; const char* b3 = b2 + kstep;
            PG8_LDB(B0, 0, 0); PG8_LDB(B1, 0, 1); PG8_SCHED; PG8_LDA(At, 0, 0); PG8_STAGE(PG8_SA(1, 1), a1 + hstepA, voffA);
            PG8_WAIT_V(8); PG8_WAIT_L(0); PG8_BAR; PG8_MMA(0, 0, At, B0); PG8_MMA(0, 1, At, B1); PG8_BAR; PG8_SCHED;
            PG8_LDA(At, 0, 1); PG8_STAGE(PG8_SB(0, 0), b2, voffB); PG8_STAGE(PG8_SB(0, 1), b2 + hstepB, voffB); PG8_STAGE(PG8_SA(0, 0), a2, voffA);
            PG8_WAIT_V(8); PG8_WAIT_L(0); PG8_BAR; PG8_MMA(1, 0, At, B0); PG8_MMA(1, 1, At, B1); PG8_BAR; PG8_SCHED;
            PG8_LDB(B0, 1, 0); PG8_LDB(B1, 1, 1); PG8_SCHED; PG8_LDA(At, 1, 0); PG8_STAGE(PG8_SA(0, 1), a2 + hstepA, voffA);
            PG8_WAIT_V(8); PG8_WAIT_L(0); PG8_BAR; PG8_MMA(0, 0, At, B0); PG8_MMA(0, 1, At, B1); PG8_BAR; PG8_SCHED;
            PG8_LDA(At, 1, 1); PG8_STAGE(PG8_SB(1, 0), b3, voffB); PG8_STAGE(PG8_SB(1, 1), b3 + hstepB, voffB); PG8_STAGE(PG8_SA(1, 0), a3, voffA);
            PG8_WAIT_V(8); PG8_WAIT_L(0); PG8_BAR; PG8_MMA(1, 0, At, B0); PG8_MMA(1, 1, At, B1); PG8_BAR; PG8_SCHED;
        }
        if (wr == 0) PG8_BAR;
        { int efr = fr, efq = fq; asm volatile("" : "+v"(efr), "+v"(efq)); E(acc, cur, wr, wc, efr, efq, lds); }
        if (!has_next) break;
#pragma unroll
        for (int a = 0; a < 2; ++a)
#pragma unroll
            for (int b = 0; b < 2; ++b)
#pragma unroll
                for (int m = 0; m < 4; ++m)
#pragma unroll
                    for (int n = 0; n < 2; ++n) acc[a][b][m][n] = (f32x4){0.f, 0.f, 0.f, 0.f};
        cur = nxt; cA = nA; cB = nB; ++ui;
        if (wr == 1) PG8_BAR;
    }
    PG8_WAIT_V(0);
    PG8_BAR;
#undef PG8_SA
#undef PG8_SB
#undef PG8_STAGE
#undef PG8_LDA
#undef PG8_LDB
#undef PG8_MMA
#undef PG8_WAIT_V
#undef PG8_WAIT_L
#undef PG8_BAR
#undef PG8_SCHED
}

struct SchedPlain {
    const char* A; const char* B; int lda, ldb, nM, nN, G, c, acol, brow;
    __device__ __forceinline__ bool next(int i, Unit& u) const {
        int pm, pn; if (!tile_order(i, G, c, nM, nN, pm, pn)) return false;
        u.A = A + ((size_t)pm * 256 * lda + (size_t)pn * acol) * 2; u.B = B + (size_t)pn * brow * ldb * 2; u.row0 = pm * 256; u.col0 = pn * 256; u.aux = 0; return true;
    }
};
struct SchedAttn {
    const char* A; const char* B; int kind, G, c;
    __device__ __forceinline__ bool next(int i, Unit& u) const {
        const int L = i * G + c; if (L >= 256) return false;
        const int b = L >> 5, h = (L >> 3) & 3, qt = L & 7;
        u.row0 = b * 2048 + qt * 256; u.col0 = h * 256; u.aux = 0;
        u.A = A + ((size_t)u.row0 * 1024 + h * 256) * 2;
        u.B = kind == 0 ? B + ((size_t)(b * 256) * 1024 + h * 256) * 2 : B + ((size_t)(b * 1024 + h * 256) * 256) * 2;
        return true;
    }
};
struct SchedKV {
    const char* memn; const char* wkv; int G, c;
    __device__ __forceinline__ bool next(int i, Unit& u) const {
        const int L = i * G + c; if (L >= 128) return false;
        const int l = L >> 6, kind = (L >> 5) & 1, idx = L & 31; u.aux = l * 2 + kind;
        const char* w = wkv + (size_t)l * 2048 * 1024 * 2;
        if (kind == 0) { const int pm = idx >> 2, pn = idx & 3; u.A = memn + (size_t)pm * 256 * 1024 * 2; u.B = w + (size_t)pn * 256 * 1024 * 2; u.row0 = pm * 256; u.col0 = pn * 256; }
        else { const int b = idx >> 2, pm = idx & 3; u.A = w + (size_t)(1024 + pm * 256) * 1024 * 2; u.B = memn + (size_t)b * 256 * 1024 * 2; u.row0 = b * 1024 + pm * 256; u.col0 = 0; }
        return true;
    }
};

#define EPI_ARGS f32x4 (&acc)[2][2][4][2], const Unit& u, int wr, int wc, int fr, int fq, LAS unsigned char* lds
#define FOR_AI_M _Pragma("unroll") for (int ai = 0; ai < 2; ++ai) _Pragma("unroll") for (int m = 0; m < 4; ++m)
#define FOR_BJ_N _Pragma("unroll") for (int bj = 0; bj < 2; ++bj) _Pragma("unroll") for (int n = 0; n < 2; ++n)
__device__ __forceinline__ void st_bf4(bf16_t* p, f32x4 v) { u32x2 w; w.x = pk2(v.x, v.y); w.y = pk2(v.z, v.w); *(u32x2*)p = w; }

struct EpiWin {
    const float* ssq; bf16_t* qkv; bf16_t* gate; float* ba; bf16_t* uo;
    __device__ __forceinline__ void operator()(EPI_ARGS) const {
        FOR_AI_M { const int row = u.row0 + 128 * ai + 64 * wr + 16 * m + fr; const float rs = rsqrtf(ssq[row] * (1.0f / 1024.0f) + EPS);
            FOR_BJ_N { const int c = u.col0 + 128 * bj + 32 * wc + 16 * n + 4 * fq; const f32x4 v = acc[ai][bj][m][n] * rs;
                if (c < 1536) st_bf4(qkv + (size_t)row * 1536 + c, v);
                else if (c < 2048) st_bf4(gate + (size_t)row * 512 + (c - 1536), v);
                else if (c < 2056) *(f32x4*)(ba + (size_t)row * 8 + (c - 2048)) = v;
                else if (c < NIN) st_bf4(uo + (size_t)row * 512 + (c - 2056), v); } }
    }
};
struct EpiRes {
    float* X; bf16_t* XB; float* ssqn; const float* colscale;
    __device__ __forceinline__ void operator()(EPI_ARGS) const {
        FOR_AI_M { const int row = u.row0 + 128 * ai + 64 * wr + 16 * m + fr; float s = 0.f;
            FOR_BJ_N { const int c = u.col0 + 128 * bj + 32 * wc + 16 * n + 4 * fq; f32x4 a = acc[ai][bj][m][n];
                if (colscale) a = a * *(const f32x4*)(colscale + c);
                float* xp = X + (size_t)row * 1024 + c; const f32x4 x = *(const f32x4*)xp + a; *(f32x4*)xp = x; st_bf4(XB + (size_t)row * 1024 + c, x);
                s += (x.x * x.x + x.y * x.y) + (x.z * x.z + x.w * x.w); }
            s += __shfl_xor(s, 16); s += __shfl_xor(s, 32);
            if (fq == 0) atomicAdd(ssqn + row, s);
            asm volatile("" ::: "memory"); }
    }
};
struct EpiScaleBf {
    const float* ssq; bf16_t* out; int ldc; float scale;
    __device__ __forceinline__ void operator()(EPI_ARGS) const {
        FOR_AI_M { const int row = u.row0 + 128 * ai + 64 * wr + 16 * m + fr; const float rs = (ssq ? rsqrtf(ssq[row] * (1.0f / 1024.0f) + EPS) : 1.0f) * scale;
            FOR_BJ_N { const int c = u.col0 + 128 * bj + 32 * wc + 16 * n + 4 * fq; st_bf4(out + (size_t)row * ldc + c, acc[ai][bj][m][n] * rs); } }
    }
};
struct EpiKV {
    bf16_t* km; bf16_t* vt;
    __device__ __forceinline__ void operator()(EPI_ARGS) const {
        const int l = u.aux >> 1, kind = u.aux & 1; bf16_t* o = kind == 0 ? km + (size_t)l * 2048 * 1024 : vt + (size_t)l * 8192 * 256; const int ldc = kind == 0 ? 1024 : 256;
        FOR_AI_M { const int row = u.row0 + 128 * ai + 64 * wr + 16 * m + fr;
            FOR_BJ_N { const int c = u.col0 + 128 * bj + 32 * wc + 16 * n + 4 * fq; st_bf4(o + (size_t)row * ldc + c, acc[ai][bj][m][n]); } }
    }
};
struct EpiGlu {
    const bf16_t* yg; const float* bias; bf16_t* mixed;
    __device__ __forceinline__ void operator()(EPI_ARGS) const {
        FOR_AI_M { const int row = u.row0 + 128 * ai + 64 * wr + 16 * m + fr;
            FOR_BJ_N { const int c = u.col0 + 128 * bj + 32 * wc + 16 * n + 4 * fq; const f32x4 z = acc[ai][bj][m][n] + *(const f32x4*)(bias + c);
                const u32x2 yw = *(const u32x2*)(yg + (size_t)row * 512 + c); f32x4 o;
                o.x = bflo(yw.x) * sigmoid_f(z.x); o.y = bfhi(yw.x) * sigmoid_f(z.y); o.z = bflo(yw.y) * sigmoid_f(z.z); o.w = bfhi(yw.y) * sigmoid_f(z.w);
                st_bf4(mixed + (size_t)row * 1024 + 512 + c, o); } }
    }
};
struct EpiSoftmax {
    bf16_t* P;
    __device__ __forceinline__ void operator()(EPI_ARGS) const {
        LAS float* smax = (LAS float*)(lds + LDS_SCR); LAS float* ssum = smax + 1024;
        FOR_AI_M { const int rl = 128 * ai + 64 * wr + 16 * m + fr; float mx = -3.0e38f;
            FOR_BJ_N { const f32x4 v = acc[ai][bj][m][n]; mx = fmaxf(mx, fmaxf(fmaxf(v.x, v.y), fmaxf(v.z, v.w))); }
            mx = fmaxf(mx, __shfl_xor(mx, 16)); mx = fmaxf(mx, __shfl_xor(mx, 32));
            if (fq == 0) smax[rl * 4 + wc] = mx; }
        LDS_BARRIER();
        FOR_AI_M { const int rl = 128 * ai + 64 * wr + 16 * m + fr; const f32x4 mm = *(const LAS f32x4*)(smax + rl * 4);
            const float mx = fmaxf(fmaxf(mm.x, mm.y), fmaxf(mm.z, mm.w)); float s = 0.f;
            FOR_BJ_N { f32x4 v = acc[ai][bj][m][n]; v.x = __expf(v.x - mx); v.y = __expf(v.y - mx); v.z = __expf(v.z - mx); v.w = __expf(v.w - mx); acc[ai][bj][m][n] = v; s += (v.x + v.y) + (v.z + v.w); }
            s += __shfl_xor(s, 16); s += __shfl_xor(s, 32);
            if (fq == 0) ssum[rl * 4 + wc] = s; }
        LDS_BARRIER();
        FOR_AI_M { const int rl = 128 * ai + 64 * wr + 16 * m + fr; const int row = u.row0 + rl; const f32x4 ss = *(const LAS f32x4*)(ssum + rl * 4);
            const float inv = 1.0f / ((ss.x + ss.y) + (ss.z + ss.w));
            FOR_BJ_N { const int c = u.col0 + 128 * bj + 32 * wc + 16 * n + 4 * fq; st_bf4(P + (size_t)row * 1024 + c, acc[ai][bj][m][n] * inv); } }
    }
};
struct EpiUp {
    const float* ssq; const float* cw; bf16_t* act; float* halo;
    __device__ __forceinline__ void operator()(EPI_ARGS) const {
        LAS float* hl = (LAS float*)(lds + LDS_SCR);
        const int pm = u.row0 >> 8, pn = u.col0 >> 8;
        FOR_AI_M { const int row = u.row0 + 128 * ai + 64 * wr + 16 * m + fr; const float rs = rsqrtf(ssq[row] * (1.0f / 1024.0f) + EPS);
            FOR_BJ_N acc[ai][bj][m][n] = acc[ai][bj][m][n] * rs; }
#pragma unroll
        for (int ai = 0; ai < 2; ++ai) { const int strip = 2 * ai + wr;
            if (fr >= 14) { const int rr = fr - 14;
                FOR_BJ_N { const int lc = 128 * bj + 32 * wc + 16 * n + 4 * fq; *(LAS f32x4*)(hl + (strip * 2 + rr) * 256 + lc) = acc[ai][bj][3][n];
                    if (strip == 3) *(f32x4*)(halo + (size_t)(pm * 4 + 2 + rr) * FF2 + u.col0 + lc) = acc[ai][bj][3][n]; } }
            if (strip == 0 && fr < 2) { FOR_BJ_N { const int lc = 128 * bj + 32 * wc + 16 * n + 4 * fq; *(f32x4*)(halo + (size_t)(pm * 4 + fr) * FF2 + u.col0 + lc) = acc[ai][bj][0][n]; } } }
        LDS_BARRIER();
#pragma unroll
        for (int ai = 0; ai < 2; ++ai) { const int strip = 2 * ai + wr;
#pragma unroll
            for (int n = 0; n < 2; ++n) {
                const int lcg = 32 * wc + 16 * n + 4 * fq; const int ch = pn * 128 + lcg;
                const f32x4 wg0 = *(const f32x4*)(cw + ch), wg1 = *(const f32x4*)(cw + FF2 + ch), wg2 = *(const f32x4*)(cw + 2 * FF2 + ch);
                const f32x4 wv0 = *(const f32x4*)(cw + FF + ch), wv1 = *(const f32x4*)(cw + FF2 + FF + ch), wv2 = *(const f32x4*)(cw + 2 * FF2 + FF + ch);
                f32x4 hg1 = (f32x4){0.f, 0.f, 0.f, 0.f}, hg2 = hg1, hv1 = hg1, hv2 = hg1;
                if (strip > 0) { const LAS float* hp = hl + (strip - 1) * 512 + lcg; hg2 = *(const LAS f32x4*)hp; hg1 = *(const LAS f32x4*)(hp + 256); hv2 = *(const LAS f32x4*)(hp + 128); hv1 = *(const LAS f32x4*)(hp + 384); }
                f32x4 pg1 = hg1, pv1 = hv1, pg2 = (fr == 1) ? hg1 : hg2, pv2 = (fr == 1) ? hv1 : hv2;
#pragma unroll
                for (int m = 0; m < 4; ++m) {
                    const f32x4 g = acc[ai][0][m][n], v = acc[ai][1][m][n];
                    const f32x4 rg1 = dpp4<0x121>(g), rg2 = dpp4<0x122>(g), rv1 = dpp4<0x121>(v), rv2 = dpp4<0x122>(v);
                    const f32x4 g1 = fr >= 1 ? rg1 : pg1, g2 = fr >= 2 ? rg2 : pg2, v1 = fr >= 1 ? rv1 : pv1, v2 = fr >= 2 ? rv2 : pv2;
                    const f32x4 cg_ = wg2 * g + wg1 * g1 + wg0 * g2, cv_ = wv2 * v + wv1 * v1 + wv0 * v2;
                    f32x4 o; o.x = silu_f(cg_.x) * cv_.x; o.y = silu_f(cg_.y) * cv_.y; o.z = silu_f(cg_.z) * cv_.z; o.w = silu_f(cg_.w) * cv_.w;
                    const int row = u.row0 + 128 * ai + 64 * wr + 16 * m + fr;
                    st_bf4(act + (size_t)row * FF + ch, o);
                    pg1 = rg1; pg2 = rg2; pv1 = rv1; pv2 = rv2;
                } } }
    }
};
}

__device__ __forceinline__ void transpose_item(const float* W, int K, int N, bf16_t* WT, const float* gain, int mode, LAS float* scr, int item, int lane) {
    const int nblk = (N + 31) / 32, kb = item / nblk, nb = item % nblk, k0 = 64 * kb, n0 = 32 * nb;
    const int nn = n0 + (lane & 31);
#pragma unroll 8
    for (int i = 0; i < 32; ++i) { const int kk = 2 * i + (lane >> 5); float v = 0.f; if (nn < N) { v = W[(size_t)(k0 + kk) * N + nn]; if (gain) v *= gain[k0 + kk]; } scr[kk * 33 + (lane & 31)] = v; }
    asm volatile("s_waitcnt lgkmcnt(0)" ::: "memory");
    const int c = lane & 7;
    int rbase = n0;
    if (mode == 1) { const int isv = n0 >= FF ? 1 : 0; const int ch = n0 - isv * FF; rbase = (ch >> 7) * 256 + isv * 128 + (ch & 127); }
#pragma unroll
    for (int j = 0; j < 4; ++j) { const int n = (lane >> 3) + 8 * j; const LAS float* s = scr + (8 * c) * 33 + n;
        u32x4 o; o.x = pk2(s[0 * 33], s[1 * 33]); o.y = pk2(s[2 * 33], s[3 * 33]); o.z = pk2(s[4 * 33], s[5 * 33]); o.w = pk2(s[6 * 33], s[7 * 33]);
        *(u32x4*)(WT + (size_t)(rbase + n) * K + k0 + 8 * c) = o; }
    asm volatile("s_waitcnt lgkmcnt(0)" ::: "memory");
}

__device__ __forceinline__ void phase_prologue(const Params& p, LAS unsigned char* lds, int G) {
    const int tid = fresh_tid(), lane = tid & 63, wave = tid >> 6;
    LAS float* scr = (LAS float*)(lds + wave * 16384);
    const int gw = blockIdx.x * 8 + wave, NGW = G * 8;
    unsigned char* ws = p.ws;
    for (int mi = 0; mi < 17; ++mi) {
        const float* W; int K, N, mode = 0; bf16_t* WT; const float* gain = nullptr;
        switch (mi) {
            case 0: W = p.in[7]; K = 1024; N = NIN; WT = (bf16_t*)(ws + O_WIN); gain = p.in[2]; break;
            case 1: W = p.in[20]; K = 512; N = 512; WT = (bf16_t*)(ws + O_WGLU); break;
            case 2: W = p.in[22]; K = 1024; N = 1024; WT = (bf16_t*)(ws + O_WOUT); break;
            case 3: W = p.in[25]; K = 1024; N = 1024; WT = (bf16_t*)(ws + O_WQ); gain = p.in[3]; break;
            case 4: W = p.in[25] + 1024 * 1024; K = 1024; N = 1024; WT = (bf16_t*)(ws + O_WQ) + 1024 * 1024; gain = p.in[3] + 1024; break;
            case 5: W = p.in[26]; K = 1024; N = 2048; WT = (bf16_t*)(ws + O_WKV); break;
            case 6: W = p.in[26] + 1024 * 2048; K = 1024; N = 2048; WT = (bf16_t*)(ws + O_WKV) + 2048 * 1024; break;
            case 7: W = p.in[27]; K = 1024; N = 1024; WT = (bf16_t*)(ws + O_WO); break;
            case 8: W = p.in[27] + 1024 * 1024; K = 1024; N = 1024; WT = (bf16_t*)(ws + O_WO) + 1024 * 1024; break;
            case 9: W = p.in[28]; K = 1024; N = FF2; WT = (bf16_t*)(ws + O_WUP); gain = p.in[4]; mode = 1; break;
            case 10: W = p.in[28] + (size_t)1024 * FF2; K = 1024; N = FF2; WT = (bf16_t*)(ws + O_WUP) + (size_t)FF2 * 1024; gain = p.in[4] + 1024; mode = 1; break;
            case 11: W = p.in[30]; K = FF; N = 1024; WT = (bf16_t*)(ws + O_WDN); break;
            case 12: W = p.in[30] + (size_t)FF * 1024; K = FF; N = 1024; WT = (bf16_t*)(ws + O_WDN) + (size_t)1024 * FF; break;
            default: W = p.in[23] + (mi - 13) * 65536; K = 256; N = 256; WT = (bf16_t*)(ws + O_POOL) + (mi - 13) * 65536; break;
        }
        const int nitems = (K / 64) * ((N + 31) / 32);
        for (int it = gw; it < nitems; it += NGW) transpose_item(W, K, N, WT, gain, mode, scr, it, lane);
    }
    { u32x4* z = (u32x4*)((bf16_t*)(ws + O_WIN) + (size_t)2592 * 1024); const int n16 = 224 * 1024 * 2 / 16;
      for (int i = blockIdx.x * 512 + tid; i < n16; i += G * 512) z[i] = (u32x4){0u, 0u, 0u, 0u}; }
    { float* s = (float*)(ws + O_SSQ) + MT; for (int i = blockIdx.x * 512 + tid; i < 6 * MT; i += G * 512) s[i] = 0.f; }
    for (int r = gw; r < 2048; r += NGW) {
        const f32x4* xr = (const f32x4*)(p.in[1] + (size_t)r * 1024) + lane; const f32x4* gr = (const f32x4*)p.in[5] + lane;
        f32x4 v[4]; float s = 0.f;
#pragma unroll
        for (int j = 0; j < 4; ++j) { v[j] = xr[64 * j]; s += (v[j].x * v[j].x + v[j].y * v[j].y) + (v[j].z * v[j].z + v[j].w * v[j].w); }
        const float rs = rsqrtf(wave_sum(s) * (1.0f / 1024.0f) + EPS);
        bf16_t* o = (bf16_t*)(ws + O_MEMN) + (size_t)r * 1024;
#pragma unroll
        for (int j = 0; j < 4; ++j) pg8::st_bf4(o + (64 * j + lane) * 4, v[j] * rs * gr[64 * j]);
    }
    for (int r = gw; r < MT; r += NGW) {
        const f32x4* xr = (const f32x4*)(p.in[0] + (size_t)r * 1024) + lane; f32x4* xo = (f32x4*)(p.out + (size_t)r * 1024) + lane;
        bf16_t* o = (bf16_t*)(ws + O_XB) + (size_t)r * 1024; float s = 0.f;
#pragma unroll
        for (int j = 0; j < 4; ++j) { const f32x4 v = xr[64 * j]; xo[64 * j] = v; pg8::st_bf4(o + (64 * j + lane) * 4, v); s += (v.x * v.x + v.y * v.y) + (v.z * v.z + v.w * v.w); }
        s = wave_sum(s); if (lane == 0) ((float*)(ws + O_SSQ))[r] = s;
    }
}

__device__ __forceinline__ void delta_prep(const Params& p, LAS unsigned char* lds, int chunk) {
    const int tid = fresh_tid(), lane = tid & 63, wave = tid >> 6;
    const int c = chunk & 31, bh = chunk >> 5, h = bh & 3, b = bh >> 2;
    const int row0 = b * SEQ + c * 64;
    LAS float* qf = (LAS float*)lds;
    LAS float* kf = qf + 64 * 132;
    LAS float* vf = kf + 64 * 132;
    LAS float* Am = vf + 64 * 132;
    LAS float* gc = Am + 64 * 68;
    LAS float* bt = gc + 64;
    unsigned char* ws = p.ws;
    const bf16_t* raw = (const bf16_t*)(ws + O_QKVRAW);
    if (tid < 384) {
        const int quad = tid % 96, seg = tid / 96, part = quad >> 5, within = (quad & 31) * 4, gcol = part * 512 + h * 128 + within;
        const float* cwp = p.in[8] + gcol;
        const f32x4 w0 = *(const f32x4*)cwp, w1 = *(const f32x4*)(cwp + 1536), w2 = *(const f32x4*)(cwp + 3072), w3 = *(const f32x4*)(cwp + 4608);
        LAS float* dst = (part == 0 ? qf : (part == 1 ? kf : vf)) + within;
        const int t0 = seg * 16;
        f32x4 x0, x1, x2;
        {
            f32x4 xs[3];
#pragma unroll
            for (int k = 0; k < 3; ++k) { const int t = t0 - 3 + k; f32x4 v = (f32x4){0.f, 0.f, 0.f, 0.f};
                if (c * 64 + t >= 0) { const u32x2 w = *(const u32x2*)(raw + (size_t)(row0 + t) * 1536 + gcol); v = (f32x4){bflo(w.x), bfhi(w.x), bflo(w.y), bfhi(w.y)}; }
                xs[k] = v; }
            x0 = xs[0]; x1 = xs[1]; x2 = xs[2];
        }
#pragma unroll 4
        for (int t = t0; t < t0 + 16; ++t) {
            const u32x2 w = *(const u32x2*)(raw + (size_t)(row0 + t) * 1536 + gcol); const f32x4 x3 = (f32x4){bflo(w.x), bfhi(w.x), bflo(w.y), bfhi(w.y)};
            const f32x4 y = w0 * x0 + w1 * x1 + w2 * x2 + w3 * x3;
            f32x4 o; o.x = silu_f(y.x); o.y = silu_f(y.y); o.z = silu_f(y.z); o.w = silu_f(y.w);
            *(LAS f32x4*)(dst + t * 132) = o;
            x0 = x1; x1 = x2; x2 = x3;
        }
    } else if (wave == 6) {
        const float* ba = (const float*)(ws + O_BA) + (size_t)(row0 + lane) * 8;
        const float al = ba[4 + h] + p.in[10][h]; const float sp = al > 20.f ? al : log1pf(expf(al));
        float g = -expf(p.in[9][h]) * sp;
#pragma unroll
        for (int o = 1; o < 64; o <<= 1) { const float t = __shfl_up(g, o); if (lane >= o) g += t; }
        gc[lane] = g; bt[lane] = sigmoid_f(ba[h]);
        if (lane == 63) ((float*)(ws + O_GL))[chunk] = expf(g);
    }
    LDS_BARRIER();
    {
        const int r = tid >> 2, qr = tid & 3; LAS float* rp = (r < 64 ? qf + r * 132 : kf + (r - 64) * 132) + qr * 32;
        f32x4 v[8]; float s = 0.f;
#pragma unroll
        for (int j = 0; j < 8; ++j) { v[j] = *(const LAS f32x4*)(rp + 4 * j); s += (v[j].x * v[j].x + v[j].y * v[j].y) + (v[j].z * v[j].z + v[j].w * v[j].w); }
        s += __shfl_xor(s, 1); s += __shfl_xor(s, 2);
        const float sc = rsqrtf(s + 1e-6f) * (r < 64 ? 0.08838834764831845f : 1.0f);
#pragma unroll
        for (int j = 0; j < 8; ++j) *(LAS f32x4*)(rp + 4 * j) = v[j] * sc;
    }
    LDS_BARRIER();
    bf16_t* dp2 = (bf16_t*)(ws + O_DP2 + (size_t)chunk * 40960);
    bf16_t* dp1 = (bf16_t*)(ws + O_DP1 + (size_t)chunk * 32768);
    for (int job = wave; job < 32; job += 8) {
        const int isqk = job >> 4, ti = (job >> 2) & 3, tj = job & 3;
        const int fr = lane & 15, fq = lane >> 4;
        const LAS float* ap = (isqk ? qf : kf) + (16 * ti + fr) * 132 + fq;
        const LAS float* bp = kf + (16 * tj + fr) * 132 + fq;
        f32x4 acc = (f32x4){0.f, 0.f, 0.f, 0.f};
#pragma unroll 8
        for (int ks = 0; ks < 32; ++ks) acc = __builtin_amdgcn_mfma_f32_16x16x4f32(ap[4 * ks], bp[4 * ks], acc, 0, 0, 0);
        const int j = 16 * tj + fr; const float gj = gc[j];
#pragma unroll
        for (int r = 0; r < 4; ++r) { const int i = 16 * ti + 4 * fq + r; const float dec = __expf(gc[i] - gj);
            if (!isqk) { Am[j * 68 + i] = (j < i) ? acc[r] * dec * bt[i] : 0.f; }
            else { const float v = (j <= i) ? acc[r] * dec : 0.f;
                const int mt = i >> 4, ii = i & 15, ks2 = j >> 5, r32 = j & 31, jj = 4 * (r32 >> 4) + (r32 & 3), q = (r32 & 15) >> 2;
                dp2[16384 + ((mt * 2 + ks2) * 64 + ii + 16 * q) * 8 + jj] = (bf16_t)f2bf(v); } }
    }
    LDS_BARRIER();
    {
        const float gl = gc[63];
#pragma unroll 1
        for (int f = tid; f < 1024; f += 512) {
            const int ln = f & 63, ii = ln & 15, q = ln >> 4;
            {
                const int mt = f >> 8, ks = (f >> 6) & 3, i = 16 * mt + ii; const float e = __expf(gc[i]);
                const LAS float* s = qf + i * 132 + 32 * ks + 4 * q; const f32x4 lo = *(const LAS f32x4*)s, hi = *(const LAS f32x4*)(s + 16);
                u32x4 o; o.x = pk2(lo.x * e, lo.y * e); o.y = pk2(lo.z * e, lo.w * e); o.z = pk2(hi.x * e, hi.y * e); o.w = pk2(hi.z * e, hi.w * e);
                *(u32x4*)(dp2 + (size_t)f * 8) = o; }
            {
                const int mt8 = f >> 7, ks2 = (f >> 6) & 1, dk = 16 * mt8 + ii; float v[8];
#pragma unroll
                for (int jj = 0; jj < 8; ++jj) { const int s = 32 * ks2 + 16 * (jj >> 2) + 4 * q + (jj & 3); v[jj] = kf[s * 132 + dk] * __expf(gl - gc[s]); }
                u32x4 o; o.x = pk2(v[0], v[1]); o.y = pk2(v[2], v[3]); o.z = pk2(v[4], v[5]); o.w = pk2(v[6], v[7]);
                *(u32x4*)(dp2 + 8192 + (size_t)f * 8) = o; }
        }
    }
    LDS_BARRIER();
    if (tid < 256) {
        const int col = tid; LAS float* buf = col < 128 ? vf + col : kf + (col - 128); const bool isw = col >= 128;
#pragma unroll 1
        for (int bi = 0; bi < 4; ++bi) {
            float acc[16];
#pragma unroll
            for (int r = 0; r < 16; ++r) { const int i = 16 * bi + r; float v = buf[i * 132] * bt[i]; if (isw) v *= __expf(gc[i]); acc[r] = v; }
#pragma unroll 2
            for (int j = 0; j < 16 * bi; ++j) {
                const float xj = buf[j * 132]; const LAS f32x4* ap = (const LAS f32x4*)(Am + j * 68 + 16 * bi);
#pragma unroll
                for (int q4 = 0; q4 < 4; ++q4) { const f32x4 a = ap[q4]; acc[4 * q4 + 0] -= a.x * xj; acc[4 * q4 + 1] -= a.y * xj; acc[4 * q4 + 2] -= a.z * xj; acc[4 * q4 + 3] -= a.w * xj; }
            }
#pragma unroll
            for (int r = 0; r < 16; ++r) {
                const float xr = acc[r]; buf[(16 * bi + r) * 132] = xr;
                const LAS float* arow = Am + (16 * bi + r) * 68 + 16 * bi;
#pragma unroll
                for (int r2 = r + 1; r2 < 16; ++r2) acc[r2] -= arow[r2] * xr;
            }
        }
    }
    LDS_BARRIER();
#pragma unroll 1
    for (int f = tid; f < 1024; f += 512) {
        { const int i = f >> 4, c8 = (f & 15) * 8; const LAS float* s = vf + i * 132 + c8; const f32x4 lo = *(const LAS f32x4*)s, hi = *(const LAS f32x4*)(s + 4);
          u32x4 o; o.x = pk2(lo.x, lo.y); o.y = pk2(lo.z, lo.w); o.z = pk2(hi.x, hi.y); o.w = pk2(hi.z, hi.w);
          *(u32x4*)(dp1 + 8192 + i * 128 + c8) = o; }
        { const int ln = f & 63, ii = ln & 15, q = ln >> 4, mt = f >> 8, ks = (f >> 6) & 3, i = 16 * mt + ii;
          const LAS float* s = kf + i * 132 + 32 * ks + 4 * q; const f32x4 lo = *(const LAS f32x4*)s, hi = *(const LAS f32x4*)(s + 16);
          u32x4 o; o.x = pk2(lo.x, lo.y); o.y = pk2(lo.z, lo.w); o.z = pk2(hi.x, hi.y); o.w = pk2(hi.z, hi.w);
          *(u32x4*)(dp1 + (size_t)f * 8) = o; }
    }
    LDS_BARRIER();
}

__device__ __forceinline__ void delta_scan(const Params& p, int item) {
    const int lane = fresh_tid() & 63, fr = lane & 15, fq = lane >> 4;
    const int bh = item >> 3, sl = item & 7, h = bh & 3, b = bh >> 2;
    unsigned char* ws = p.ws;
    float* od = (float*)(ws + O_ODELTA);
    f32x4 S[8];
#pragma unroll
    for (int i = 0; i < 8; ++i) S[i] = (f32x4){0.f, 0.f, 0.f, 0.f};
#pragma unroll 1
    for (int c = 0; c < 32; ++c) {
        const int chunk = bh * 32 + c;
        const bf16x8* wf = (const bf16x8*)(ws + O_DP1 + (size_t)chunk * 32768) + lane;
        const bf16_t* uu = (const bf16_t*)(ws + O_DP1 + (size_t)chunk * 32768 + 16384);
        const bf16x8* qg = (const bf16x8*)(ws + O_DP2 + (size_t)chunk * 40960) + lane;
        const bf16x8* kd = qg + 1024; const bf16x8* qk = qg + 2048;
        const float gl = ((const float*)(ws + O_GL))[chunk];
        bf16x8 bS[4];
#pragma unroll
        for (int ks = 0; ks < 4; ++ks) { u32x4 w; w.x = pk2(S[2 * ks].x, S[2 * ks].y); w.y = pk2(S[2 * ks].z, S[2 * ks].w); w.z = pk2(S[2 * ks + 1].x, S[2 * ks + 1].y); w.w = pk2(S[2 * ks + 1].z, S[2 * ks + 1].w); bS[ks] = __builtin_bit_cast(bf16x8, w); }
        f32x4 vn[4], o[4];
#pragma unroll
        for (int mt = 0; mt < 4; ++mt) {
            f32x4 a = (f32x4){0.f, 0.f, 0.f, 0.f}, q = a;
#pragma unroll
            for (int ks = 0; ks < 4; ++ks) { a = __builtin_amdgcn_mfma_f32_16x16x32_bf16(wf[(mt * 4 + ks) * 64], bS[ks], a, 0, 0, 0); q = __builtin_amdgcn_mfma_f32_16x16x32_bf16(qg[(mt * 4 + ks) * 64], bS[ks], q, 0, 0, 0); }
            f32x4 uv;
#pragma unroll
            for (int r = 0; r < 4; ++r) uv[r] = bf1(uu[(16 * mt + 4 * fq + r) * 128 + 16 * sl + fr]);
            vn[mt] = uv - a; o[mt] = q;
        }
        __builtin_amdgcn_sched_barrier(0);
        bf16x8 bV[2];
#pragma unroll
        for (int ks = 0; ks < 2; ++ks) { u32x4 w; w.x = pk2(vn[2 * ks].x, vn[2 * ks].y); w.y = pk2(vn[2 * ks].z, vn[2 * ks].w); w.z = pk2(vn[2 * ks + 1].x, vn[2 * ks + 1].y); w.w = pk2(vn[2 * ks + 1].z, vn[2 * ks + 1].w); bV[ks] = __builtin_bit_cast(bf16x8, w); }
#pragma unroll
        for (int mt = 0; mt < 4; ++mt) {
#pragma unroll
            for (int ks = 0; ks < 2; ++ks) o[mt] = __builtin_amdgcn_mfma_f32_16x16x32_bf16(qk[(mt * 2 + ks) * 64], bV[ks], o[mt], 0, 0, 0);
            const int rowb = b * SEQ + c * 64 + 16 * mt + 4 * fq;
#pragma unroll
            for (int r = 0; r < 4; ++r) od[(size_t)(rowb + r) * 512 + h * 128 + 16 * sl + fr] = o[mt][r];
        }
        __builtin_amdgcn_sched_barrier(0);
#pragma unroll
        for (int m8 = 0; m8 < 8; ++m8) {
            f32x4 s = S[m8] * gl;
#pragma unroll
            for (int ks = 0; ks < 2; ++ks) s = __builtin_amdgcn_mfma_f32_16x16x32_bf16(kd[(m8 * 2 + ks) * 64], bV[ks], s, 0, 0, 0);
            S[m8] = s;
        }
    }
}

struct S5C { float lbr, lbi; float bbr[16], bbi[16]; };
__device__ __forceinline__ void s5_consts(const Params& p, int g, int lane, float& lbr, float& lbi, float (&bbr)[16], float (&bbi)[16]) {
    const float dt = expf(p.in[19][g]); const float lr = p.in[12][g * 64 + lane], li = p.in[13][g * 64 + lane];
    const float mag = expf(lr * dt); float sn, cs; sincosf(li * dt, &sn, &cs); lbr = mag * cs; lbi = mag * sn;
    const float den = lr * lr + li * li, nr = lbr - 1.0f, ni = lbi; const float cr = (nr * lr + ni * li) / den, ci = (ni * lr - nr * li) / den;
    const f32x4* br4 = (const f32x4*)(p.in[14] + (size_t)(g * 64 + lane) * 16); const f32x4* bi4 = (const f32x4*)(p.in[15] + (size_t)(g * 64 + lane) * 16);
#pragma unroll
    for (int q = 0; q < 4; ++q) { const f32x4 br = br4[q], bi = bi4[q];
#pragma unroll
        for (int k = 0; k < 4; ++k) { bbr[4 * q + k] = cr * br[k] - ci * bi[k]; bbi[4 * q + k] = cr * bi[k] + ci * br[k]; } }
}
#define S5_STEP(t) do { float bur = 0.f, bui = 0.f; \
    _Pragma("unroll") for (int k = 0; k < 8; ++k) { const unsigned w = (unsigned)__builtin_amdgcn_readlane((int)ur[k], (t)); const float u0 = bflo(w), u1 = bfhi(w); \
        bur += bbr[2 * k] * u0; bui += bbi[2 * k] * u0; bur += bbr[2 * k + 1] * u1; bui += bbi[2 * k + 1] * u1; } \
    const float nxr = lbr * xr - lbi * xi + bur, nxi = lbr * xi + lbi * xr + bui; xr = nxr; xi = nxi; } while (0)

__device__ __forceinline__ void s5_pass1(const Params& p, int unit) {
    const int lane = fresh_tid() & 63; const int c = unit & 31, g = (unit >> 5) & 31, b = unit >> 10;
    float lbr, lbi, bbr[16], bbi[16]; s5_consts(p, g, lane, lbr, lbi, bbr, bbi);
    const bf16_t* up = (const bf16_t*)(p.ws + O_U) + (size_t)(b * SEQ + c * 64 + lane) * 512 + g * 16;
    unsigned ur[8]; { const u32x4 a = *(const u32x4*)up, bq = *(const u32x4*)(up + 8); ur[0] = a.x; ur[1] = a.y; ur[2] = a.z; ur[3] = a.w; ur[4] = bq.x; ur[5] = bq.y; ur[6] = bq.z; ur[7] = bq.w; }
    float xr = 0.f, xi = 0.f;
#pragma unroll 4
    for (int t = 0; t < 64; ++t) S5_STEP(t);
    float* xe = (float*)(p.ws + O_XEND) + ((size_t)unit * 64 + lane) * 2; xe[0] = xr; xe[1] = xi;
}
__device__ __forceinline__ void s5_combine(const Params& p, int idx) {
    const int pp = idx & 63, g = (idx >> 6) & 31, b = idx >> 11;
    const float dt = expf(p.in[19][g]); const float lr = p.in[12][g * 64 + pp], li = p.in[13][g * 64 + pp];
    const float mag = expf(lr * dt); float sn, cs; sincosf(li * dt, &sn, &cs); float ar = mag * cs, ai = mag * sn;
#pragma unroll
    for (int k = 0; k < 6; ++k) { const float nr = ar * ar - ai * ai, ni = 2.0f * ar * ai; ar = nr; ai = ni; }
    float xr = 0.f, xi = 0.f;
    const float* xe = (const float*)(p.ws + O_XEND); float* xp = (float*)(p.ws + O_XPREV);
    for (int c = 0; c < 32; ++c) { const size_t o = (((size_t)(b * 32 + g) * 32 + c) * 64 + pp) * 2;
        xp[o] = xr; xp[o + 1] = xi; const float er = xe[o], ei = xe[o + 1];
        const float nr = ar * xr - ai * xi + er, ni = ar * xi + ai * xr + ei; xr = nr; xi = ni; }
}
__device__ __forceinline__ void s5_pass2(const Params& p, LAS unsigned char* lds, int unit) {
    const int tid2 = fresh_tid(); const int lane = tid2 & 63, wave = tid2 >> 6, fr = lane & 15, fq = lane >> 4;
    const int c = unit & 31, g = (unit >> 5) & 31, b = unit >> 10;
    LAS float* XS = (LAS float*)(lds + wave * 8448);
    float lbr, lbi, bbr[16], bbi[16]; s5_consts(p, g, lane, lbr, lbi, bbr, bbi);
    const int rowb = b * SEQ + c * 64;
    const bf16_t* ub = (const bf16_t*)(p.ws + O_U);
    const bf16_t* up = ub + (size_t)(rowb + lane) * 512 + g * 16;
    unsigned ur[8]; { const u32x4 a = *(const u32x4*)up, bq = *(const u32x4*)(up + 8); ur[0] = a.x; ur[1] = a.y; ur[2] = a.z; ur[3] = a.w; ur[4] = bq.x; ur[5] = bq.y; ur[6] = bq.z; ur[7] = bq.w; }
    float cc[32];
#pragma unroll
    for (int ks = 0; ks < 32; ++ks) { const int k = 4 * ks + fq; cc[ks] = ks < 16 ? p.in[16][(size_t)(g * 16 + fr) * 64 + k] : -p.in[17][(size_t)(g * 16 + fr) * 64 + (k - 64)]; }
    const f32x4 dd = *(const f32x4*)(p.in[18] + g * 16 + 4 * fq);
    const float* xp = (const float*)(p.ws + O_XPREV) + ((size_t)unit * 64 + lane) * 2;
    float xr = xp[0], xi = xp[1];
    bf16_t* yg = (bf16_t*)(p.ws + O_YG);
#pragma unroll 1
    for (int sc = 0; sc < 4; ++sc) {
#pragma unroll 4
        for (int t16 = 0; t16 < 16; ++t16) { S5_STEP(sc * 16 + t16); XS[t16 * 130 + lane] = xr; XS[t16 * 130 + 64 + lane] = xi; }
        asm volatile("s_waitcnt lgkmcnt(0)" ::: "memory");
        f32x4 acc = (f32x4){0.f, 0.f, 0.f, 0.f};
#pragma unroll
        for (int ks = 0; ks < 32; ++ks) acc = __builtin_amdgcn_mfma_f32_16x16x4f32(cc[ks], XS[fr * 130 + 4 * ks + fq], acc, 0, 0, 0);
        const int row = rowb + sc * 16 + fr;
        const u32x2 uw = *(const u32x2*)(ub + (size_t)row * 512 + g * 16 + 4 * fq);
        f32x4 y; y.x = acc[0] + dd.x * bflo(uw.x); y.y = acc[1] + dd.y * bfhi(uw.x); y.z = acc[2] + dd.z * bflo(uw.y); y.w = acc[3] + dd.w * bfhi(uw.y);
        y.x = gelu_tanh(y.x); y.y = gelu_tanh(y.y); y.z = gelu_tanh(y.z); y.w = gelu_tanh(y.w);
        pg8::st_bf4(yg + (size_t)row * 512 + g * 16 + 4 * fq, y);
        asm volatile("s_waitcnt lgkmcnt(0)" ::: "memory");
    }
}

constexpr size_t O_BAR = 524288;
#define XB_TMO      128
#define XB_XCNT(j)  (256  + 64 * (j))
#define XB_XSUB(j)  (1280 + 64 * (j))
#define XB_XGEN(j)  (2304 + 64 * (j))
#define XB_TOP      3328
#define XB_TOPGEN   3392
#define XCD_BAR_WORDS 3456
#define XB_SPIN_CAP (1u << 22)
__device__ __forceinline__ unsigned xb_ld(unsigned* p)              { return __hip_atomic_load(p, __ATOMIC_RELAXED, __HIP_MEMORY_SCOPE_AGENT); }
__device__ __forceinline__ unsigned xb_add(unsigned* p, unsigned v) { return __hip_atomic_fetch_add(p, v, __ATOMIC_RELAXED, __HIP_MEMORY_SCOPE_AGENT); }
__device__ __forceinline__ unsigned xb_xcc_id() { return (unsigned)__builtin_amdgcn_s_getreg((3 << 11) | 20) & 0xFu; }
#define XB_SPIN(cond, bar) do { unsigned _sp = 0; while (cond) { __builtin_amdgcn_s_sleep(1); \
    if ((++_sp & 255u) == 0u) { if (xb_ld(&(bar)[XB_TMO])) break; if (_sp > XB_SPIN_CAP) { atomicAdd(&(bar)[XB_TMO], 1u); break; } } } } while (0)
struct XcdBarrier { unsigned* bar; unsigned x; volatile LAS unsigned* st; };
__device__ __forceinline__ XcdBarrier xcd_barrier_post(unsigned* bar, volatile LAS unsigned* st) {
    XcdBarrier b; b.bar = bar; b.x = xb_xcc_id(); b.st = st;
    if (threadIdx.x == 0) (void)xb_add(&bar[XB_XCNT(b.x)], 1u);
    return b;
}
__device__ __forceinline__ void xcd_barrier_complete(unsigned* bar, unsigned x, unsigned& nloc, unsigned& nx) {
    const unsigned G = gridDim.x * gridDim.y * gridDim.z;
    unsigned sum, cnt, mine, sp = 0u;
    for (;;) {
        sum = 0u; cnt = 0u; mine = 0u;
#pragma unroll
        for (unsigned j = 0; j < 16; ++j) { const unsigned c = xb_ld(&bar[XB_XCNT(j)]); sum += c; cnt += (c > 0u) ? 1u : 0u; mine = (j == x) ? c : mine; }
        if (sum == G) break;
        __builtin_amdgcn_s_sleep(1);
        if ((++sp & 255u) == 0u) { if (xb_ld(&bar[XB_TMO])) break; if (sp > XB_SPIN_CAP) { atomicAdd(&bar[XB_TMO], 1u); break; } }
    }
    nloc = mine > 0u ? mine : 1u; nx = cnt > 0u ? cnt : 1u;
}
__device__ __forceinline__ void xcd_barrier(const XcdBarrier& b) {
    asm volatile("s_waitcnt vmcnt(0)" ::: "memory");
    __syncthreads();
    if (threadIdx.x == 0) {
        unsigned* bar = b.bar;
        __builtin_amdgcn_s_waitcnt(0);
        unsigned nloc = b.st[0], nx = b.st[1];
        if (nloc == 0u) { xcd_barrier_complete(bar, b.x, nloc, nx); b.st[0] = nloc; b.st[1] = nx; }
        const unsigned old = xb_add(&bar[XB_XSUB(b.x)], 1u);
        const unsigned gen = old / nloc;
        if (old + 1u == (gen + 1u) * nloc) {
            __builtin_amdgcn_fence(__ATOMIC_RELEASE, "agent");
            asm volatile("s_waitcnt vmcnt(0)" ::: "memory");
            const unsigned og = xb_add(&bar[XB_TOP], 1u);
            const unsigned tg = og / nx;
            if (og + 1u == (tg + 1u) * nx) xb_add(&bar[XB_TOPGEN], 1u);
            else XB_SPIN(xb_ld(&bar[XB_TOPGEN]) == tg, bar);
            __builtin_amdgcn_fence(__ATOMIC_ACQUIRE, "agent");
            xb_add(&bar[XB_XGEN(b.x)], 1u);
            asm volatile("s_waitcnt vmcnt(0)" ::: "memory");
        } else {
            XB_SPIN(xb_ld(&bar[XB_XGEN(b.x)]) == gen, bar);
            __builtin_amdgcn_fence(__ATOMIC_ACQUIRE, "agent");
            asm volatile("s_waitcnt vmcnt(0)" ::: "memory");
        }
    }
    __syncthreads();
}

template <int ONLYT> __global__ void __launch_bounds__(512) fwd_kernel(Params p) {
    extern __shared__ __attribute__((aligned(16))) unsigned char lds_raw[];
    LAS unsigned char* lds = (LAS unsigned char*)lds_raw;
    cg::grid_group grid = cg::this_grid();
    const int G = gridDim.x, bx = blockIdx.x;
    unsigned char* ws = p.ws;
    float* SSQ = (float*)(ws + O_SSQ);
    float* X = p.out; bf16_t* XB = (bf16_t*)(ws + O_XB);

    volatile LAS unsigned* bst = (volatile LAS unsigned*)(lds + LDS_BYTES - 64);
    if (threadIdx.x < 2) bst[threadIdx.x] = 0u;
    __syncthreads();
    XcdBarrier xbar; xbar.bar = (unsigned*)(ws + O_BAR); xbar.x = 0; xbar.st = bst;
    if (ONLYT < 0) xbar = xcd_barrier_post((unsigned*)(ws + O_BAR), bst);
#define GRID_SYNC() do { if (ONLYT < 0) xcd_barrier(xbar); } while (0)
    if (PH(0)) phase_prologue(p, lds, G);
    if (ONLYT < 0) grid.sync();

    if (PH(1)) {
        pg8::SchedPlain S{(const char*)XB, (const char*)(ws + O_WIN), 1024, 1024, 64, 11, G, bx, 0, 256};
        pg8::EpiWin E{SSQ, (bf16_t*)(ws + O_QKVRAW), (bf16_t*)(ws + O_GATE), (float*)(ws + O_BA), (bf16_t*)(ws + O_U)};
        pg8::gemm_phase(lds, 1024, 1024, 1024, S, E);
        pg8::SchedKV S2{(const char*)(ws + O_MEMN), (const char*)(ws + O_WKV), G, (bx + 64) % G};
        pg8::EpiKV E2{(bf16_t*)(ws + O_KM), (bf16_t*)(ws + O_VT)};
        pg8::gemm_phase(lds, 1024, 1024, 1024, S2, E2);
    }
    GRID_SYNC();

    if (PH(2)) for (int ch = bx; ch < 1024; ch += G) delta_prep(p, lds, ch);
    if (PH(3)) for (int un = bx * 8 + (fresh_tid() >> 6); un < 8192; un += G * 8) s5_pass1(p, un);
    GRID_SYNC();

    if (PH(4)) for (int i = bx * 512 + fresh_tid(); i < 16384; i += G * 512) s5_combine(p, i);
    GRID_SYNC();

    { const int wave = fresh_tid() >> 6;
    if (wave == 0) { if (PH(5)) for (int it = bx; it < 256; it += G) delta_scan(p, it); }
    else { if (PH(6)) for (int un = bx * 7 + (wave - 1); un < 8192; un += G * 7) s5_pass2(p, lds, un); } }
    GRID_SYNC();

    if (PH(7)) {
        const int tid = fresh_tid(), lane = tid & 63, wave = tid >> 6;
        const float* od = (const float*)(ws + O_ODELTA); const bf16_t* gt = (const bf16_t*)(ws + O_GATE); bf16_t* mx = (bf16_t*)(ws + O_MIXED);
        const f32x4* og = (const f32x4*)(p.in[11] + (lane & 15) * 8);
        const f32x4 g0 = og[0], g1 = og[1];
        for (int r = bx * 8 + wave; r < MT; r += G * 8) {
            const f32x4* op = (const f32x4*)(od + (size_t)r * 512 + lane * 8); const f32x4 a = op[0], bq = op[1];
            float s = (a.x * a.x + a.y * a.y) + (a.z * a.z + a.w * a.w) + (bq.x * bq.x + bq.y * bq.y) + (bq.z * bq.z + bq.w * bq.w);
            s += __shfl_xor(s, 1); s += __shfl_xor(s, 2); s += __shfl_xor(s, 4); s += __shfl_xor(s, 8);
            const float rs = rsqrtf(s * (1.0f / 128.0f) + EPS);
            const u32x4 gw = *(const u32x4*)(gt + (size_t)r * 512 + lane * 8);
            u32x4 o;
            o.x = pk2(a.x * rs * g0.x * silu_f(bflo(gw.x)), a.y * rs * g0.y * silu_f(bfhi(gw.x)));
            o.y = pk2(a.z * rs * g0.z * silu_f(bflo(gw.y)), a.w * rs * g0.w * silu_f(bfhi(gw.y)));
            o.z = pk2(bq.x * rs * g1.x * silu_f(bflo(gw.z)), bq.y * rs * g1.y * silu_f(bfhi(gw.z)));
            o.w = pk2(bq.z * rs * g1.z * silu_f(bflo(gw.w)), bq.w * rs * g1.w * silu_f(bfhi(gw.w)));
            *(u32x4*)(mx + (size_t)r * 1024 + lane * 8) = o;
        }
    }
    if (PH(8)) {
        pg8::SchedPlain S{(const char*)(ws + O_YG), (const char*)(ws + O_WGLU), 512, 512, 64, 2, G, bx, 0, 256};
        pg8::EpiGlu E{(const bf16_t*)(ws + O_YG), p.in[21], (bf16_t*)(ws + O_MIXED)};
        pg8::gemm_phase(lds, 512, 512, 512, S, E);
    }
    GRID_SYNC();

    if (PH(9)) {
        pg8::SchedPlain S{(const char*)(ws + O_MIXED), (const char*)(ws + O_WOUT), 1024, 1024, 64, 4, G, bx, 0, 256};
        pg8::EpiRes E{X, XB, SSQ + 1 * MT, nullptr};
        pg8::gemm_phase(lds, 1024, 1024, 1024, S, E);
    }
    GRID_SYNC();

#pragma unroll 1
    for (int layer = p.l_lo; layer < p.l_hi; ++layer) {
        if (layer == 1) {
          if (PH(10)) {
            const int tid = fresh_tid();
            const float* ssq = SSQ + 3 * MT; const float* gm = p.in[2] + 1024; bf16_t* dp = (bf16_t*)(ws + O_DPOOL);
            for (int seg = bx; seg < 256; seg += G) {
                const int q = tid & 255, hh = tid >> 8, col = 4 * q, w = 2 << (q >> 6);
                const int r0 = seg * 64 + hh * 32; const f32x4 gg = *(const f32x4*)(gm + col);
                f32x4 s = (f32x4){0.f, 0.f, 0.f, 0.f};
                for (int k = w - 1; k >= 1; --k) { const int r = r0 - k; if ((r0 & 2047) - k >= 0) { const float rs = rsqrtf(ssq[r] * (1.0f / 1024.0f) + EPS); s = s + *(const f32x4*)(X + (size_t)r * 1024 + col) * rs * gg; } }
                for (int i = 0; i < 32; ++i) { const int r = r0 + i, ts = r & 2047;
                    const float rs = rsqrtf(ssq[r] * (1.0f / 1024.0f) + EPS); const f32x4 xn = *(const f32x4*)(X + (size_t)r * 1024 + col) * rs * gg;
                    s = s + xn; const float inv = 1.0f / (float)(ts + 1 < w ? ts + 1 : w);
                    pg8::st_bf4(dp + (size_t)r * 1024 + col, s * inv - xn);
                    if (ts - w + 1 >= 0) { const int rl = r - w + 1; const float rl_s = rsqrtf(ssq[rl] * (1.0f / 1024.0f) + EPS); s = s - *(const f32x4*)(X + (size_t)rl * 1024 + col) * rl_s * gg; } }
            }
          }
            GRID_SYNC();
            if (PH(19)) {
                pg8::SchedPlain S{(const char*)(ws + O_DPOOL), (const char*)(ws + O_POOL), 1024, 256, 64, 4, G, bx, 256, 256};
                pg8::EpiRes E{X, XB, SSQ + 4 * MT, p.in[24]};
                pg8::gemm_phase(lds, 1024, 256, 256, S, E);
            }
            GRID_SYNC();
        }
        const int sx = layer == 0 ? 1 : 4;
        if (PH(11)) {
            pg8::SchedPlain S{(const char*)XB, (const char*)(ws + O_WQ + (size_t)layer * 2097152), 1024, 1024, 64, 4, G, bx, 0, 256};
            pg8::EpiScaleBf E{SSQ + sx * MT, (bf16_t*)(ws + O_Q), 1024, 0.0625f};
            pg8::gemm_phase(lds, 1024, 1024, 1024, S, E);
        }
        GRID_SYNC();
        if (PH(12)) {
            pg8::SchedAttn S{(const char*)(ws + O_Q), (const char*)(ws + O_KM + (size_t)layer * 4194304), 0, G, bx};
            pg8::EpiSoftmax E{(bf16_t*)(ws + O_P)};
            pg8::gemm_phase(lds, 1024, 1024, 256, S, E);
        }
        GRID_SYNC();
        if (PH(13)) {
            pg8::SchedAttn S{(const char*)(ws + O_P), (const char*)(ws + O_VT + (size_t)layer * 4194304), 1, G, bx};
            pg8::EpiScaleBf E{nullptr, (bf16_t*)(ws + O_O), 1024, 1.0f};
            pg8::gemm_phase(lds, 1024, 256, 256, S, E);
        }
        GRID_SYNC();
        if (PH(14)) {
            pg8::SchedPlain S{(const char*)(ws + O_O), (const char*)(ws + O_WO + (size_t)layer * 2097152), 1024, 1024, 64, 4, G, bx, 0, 256};
            pg8::EpiRes E{X, XB, SSQ + (sx + 1) * MT, nullptr};
            pg8::gemm_phase(lds, 1024, 1024, 1024, S, E);
        }
        GRID_SYNC();
        if (PH(15)) {
            pg8::SchedPlain S{(const char*)XB, (const char*)(ws + O_WUP + (size_t)layer * 11534336), 1024, 1024, 64, 22, G, bx, 0, 256};
            pg8::EpiUp E{SSQ + (sx + 1) * MT, p.in[29] + (size_t)layer * 3 * FF2, (bf16_t*)(ws + O_ACT), (float*)(ws + O_HALO)};
            pg8::gemm_phase(lds, 1024, 1024, 1024, S, E);
        }
        GRID_SYNC();
        if (PH(16)) {
            const int tid = fresh_tid();
            const float* hl = (const float*)(ws + O_HALO); const float* cw = p.in[29] + (size_t)layer * 3 * FF2; bf16_t* act = (bf16_t*)(ws + O_ACT);
            for (int i = bx * 512 + tid; i < 64 * FF; i += G * 512) {
                const int pm = i / FF, ch = i - pm * FF; if ((pm & 7) == 0) continue;
                const int pg = (ch >> 7) * 256 + (ch & 127), pv = pg + 128;
                const float* hp = hl + (size_t)(pm - 1) * 4 * FF2; const float* hc = hl + (size_t)pm * 4 * FF2;
                const float gm2 = hp[2 * FF2 + pg], gm1 = hp[3 * FF2 + pg], g0 = hc[pg], g1 = hc[FF2 + pg];
                const float vm2 = hp[2 * FF2 + pv], vm1 = hp[3 * FF2 + pv], v0 = hc[pv], v1 = hc[FF2 + pv];
                const float a0 = cw[ch], a1 = cw[FF2 + ch], a2 = cw[2 * FF2 + ch], b0 = cw[FF + ch], b1 = cw[FF2 + FF + ch], b2 = cw[2 * FF2 + FF + ch];
                const float o0 = silu_f(a2 * g0 + a1 * gm1 + a0 * gm2) * (b2 * v0 + b1 * vm1 + b0 * vm2);
                const float o1 = silu_f(a2 * g1 + a1 * g0 + a0 * gm1) * (b2 * v1 + b1 * v0 + b0 * vm1);
                act[(size_t)(pm * 256) * FF + ch] = (bf16_t)f2bf(o0); act[(size_t)(pm * 256 + 1) * FF + ch] = (bf16_t)f2bf(o1);
            }
        }
        GRID_SYNC();
        if (PH(17)) {
            pg8::SchedPlain S{(const char*)(ws + O_ACT), (const char*)(ws + O_WDN + (size_t)layer * 5767168), FF, FF, 64, 4, G, bx, 0, 256};
            pg8::EpiRes E{X, XB, SSQ + (sx + 2) * MT, nullptr};
            pg8::gemm_phase(lds, FF, FF, FF, S, E);
        }
        GRID_SYNC();
    }
    if (PH(18)) {
        const int tid = fresh_tid(), lane = tid & 63, wave = tid >> 6;
        const float* ssq = SSQ + 6 * MT; const f32x4* gf = (const f32x4*)p.in[6] + lane;
        for (int r = bx * 8 + wave; r < MT; r += G * 8) {
            const float rs = rsqrtf(ssq[r] * (1.0f / 1024.0f) + EPS); f32x4* xp = (f32x4*)(X + (size_t)r * 1024) + lane;
#pragma unroll
            for (int j = 0; j < 4; ++j) xp[64 * j] = xp[64 * j] * rs * gf[64 * j];
        }
    }
}

#ifndef MULTI_LAUNCH
#define MULTI_LAUNCH 0
#endif
template <int K> static void launch_phase(const Params& p, int lo, int hi, int grid, hipStream_t stream) {
    static bool attr = false;
    if (!attr) { (void)hipFuncSetAttribute((const void*)fwd_kernel<K>, hipFuncAttributeMaxDynamicSharedMemorySize, LDS_BYTES); attr = true; }
    Params q = p; q.l_lo = lo; q.l_hi = hi;
    hipLaunchKernelGGL(fwd_kernel<K>, dim3(grid), dim3(512), LDS_BYTES, stream, q);
}
extern "C" void kernel_launch(void* const* d_in, const int* in_sizes, int n_in, void* d_out, int out_size, void* d_ws, size_t ws_size, hipStream_t stream) {
    Params p{};
    for (int i = 0; i < 31; ++i) p.in[i] = (const float*)d_in[i];
    p.out = (float*)d_out; p.ws = (unsigned char*)d_ws; p.l_lo = 0; p.l_hi = 2;
#if MULTI_LAUNCH
    const int g = 256;
    launch_phase<0>(p, 0, 0, g, stream); launch_phase<1>(p, 0, 0, g, stream); launch_phase<2>(p, 0, 0, g, stream); launch_phase<3>(p, 0, 0, g, stream);
    launch_phase<4>(p, 0, 0, g, stream); launch_phase<5>(p, 0, 0, g, stream); launch_phase<6>(p, 0, 0, g, stream); launch_phase<7>(p, 0, 0, g, stream);
    launch_phase<8>(p, 0, 0, g, stream); launch_phase<9>(p, 0, 0, g, stream);
    for (int l = 0; l < 2; ++l) {
        if (l == 1) { launch_phase<10>(p, 1, 2, g, stream); launch_phase<19>(p, 1, 2, g, stream); }
        launch_phase<11>(p, l, l + 1, g, stream); launch_phase<12>(p, l, l + 1, g, stream); launch_phase<13>(p, l, l + 1, g, stream); launch_phase<14>(p, l, l + 1, g, stream);
        launch_phase<15>(p, l, l + 1, g, stream); launch_phase<16>(p, l, l + 1, g, stream); launch_phase<17>(p, l, l + 1, g, stream);
    }
    launch_phase<18>(p, 0, 0, g, stream);
#else
    static int grid_blocks = 0;
    if (!grid_blocks) {
        int dev = 0, cus = 0, per_cu = 0;
        (void)hipGetDevice(&dev);
        (void)hipDeviceGetAttribute(&cus, hipDeviceAttributeMultiprocessorCount, dev);
        (void)hipFuncSetAttribute((const void*)fwd_kernel<-1>, hipFuncAttributeMaxDynamicSharedMemorySize, LDS_BYTES);
        (void)hipOccupancyMaxActiveBlocksPerMultiprocessor(&per_cu, (const void*)fwd_kernel<-1>, 512, LDS_BYTES);
        if (per_cu < 1) { fprintf(stderr, "occupancy query returned %d\n", per_cu); per_cu = 1; }
        grid_blocks = cus * per_cu;
        if (grid_blocks > 256) grid_blocks = 256;
    }
    (void)hipMemsetAsync((char*)d_ws + O_BAR, 0, 16384, stream);
    void* args[] = {&p};
    hipError_t e = hipLaunchCooperativeKernel((const void*)fwd_kernel<-1>, dim3(grid_blocks), dim3(512), args, LDS_BYTES, stream);
    if (e != hipSuccess) fprintf(stderr, "cooperative launch failed: %s (grid %d)\n", hipGetErrorString(e), grid_blocks);
#endif
}
```

```cpp
#include <hip/hip_runtime.h>
#include <hip/hip_cooperative_groups.h>
#include <cstdio>
#include <cstdint>
namespace cg = cooperative_groups;

#define LAS __attribute__((address_space(3)))
typedef unsigned short bf16_t;
typedef short bf16x8 __attribute__((ext_vector_type(8)));
typedef float f32x4 __attribute__((ext_vector_type(4)));
typedef unsigned u32x4 __attribute__((ext_vector_type(4)));
typedef unsigned u32x2 __attribute__((ext_vector_type(2)));

constexpr int MT = 16384, DM = 1024, SEQ = 2048, NBATCH = 8;
constexpr int NIN = 2568, FF = 2816, FF2 = 5632;
constexpr float EPS = 1e-6f;
constexpr size_t HM = 524288;
constexpr size_t O_SSQ = 0;
constexpr size_t O_GL = 480 * 1024;
constexpr size_t O_WIN = 2 * HM;
constexpr size_t O_WGLU = 13 * HM;
constexpr size_t O_WOUT = 14 * HM;
constexpr size_t O_WQ = 18 * HM;
constexpr size_t O_WKV = 26 * HM;
constexpr size_t O_WO = 42 * HM;
constexpr size_t O_WUP = 50 * HM;
constexpr size_t O_WDN = 94 * HM;
constexpr size_t O_POOL = 116 * HM;
constexpr size_t O_MEMN = 117 * HM;
constexpr size_t O_KM = 125 * HM;
constexpr size_t O_VT = 141 * HM;
constexpr size_t O_XEND = 157 * HM;
constexpr size_t O_XPREV = 165 * HM;
constexpr size_t O_BA = 173 * HM;
constexpr size_t O_HALO = 174 * HM;
constexpr size_t O_XB = 186 * HM;
constexpr size_t O_R = 250 * HM;
constexpr size_t O_QKVRAW = O_R;
constexpr size_t O_GATE = O_R + 96 * HM;
constexpr size_t O_U = O_R + 128 * HM;
constexpr size_t O_DP2 = O_R + 160 * HM;
constexpr size_t O_DP1 = O_XB;
constexpr size_t O_ODELTA = O_R;
constexpr size_t O_YG = O_R + 64 * HM;
constexpr size_t O_MIXED = O_R + 160 * HM;
constexpr size_t O_Q = O_R;
constexpr size_t O_P = O_R + 64 * HM;
constexpr size_t O_O = O_R;
constexpr size_t O_ACT = O_R;
constexpr size_t O_DPOOL = O_R;
constexpr int LDS_BYTES = 163840;
constexpr int LDS_SCR = 131072;

struct Params { const float* in[31]; float* out; unsigned char* ws; int l_lo, l_hi; };
#define PH(k) (ONLYT < 0 || ONLYT == (k))

__device__ __forceinline__ unsigned f2bf(float f) { unsigned u = __float_as_uint(f); return (u + 0x7fffu + ((u >> 16) & 1u)) >> 16; }
typedef float f32x2_t __attribute__((ext_vector_type(2))); typedef __bf16 bf16x2_t __attribute__((ext_vector_type(2)));
__device__ __forceinline__ unsigned pk2(float lo, float hi) { const f32x2_t v = {lo, hi}; const bf16x2_t b = __builtin_convertvector(v, bf16x2_t); return __builtin_bit_cast(unsigned, b); }
__device__ __forceinline__ float bflo(unsigned w) { return __uint_as_float(w << 16); }
__device__ __forceinline__ float bfhi(unsigned w) { return __uint_as_float(w & 0xffff0000u); }
__device__ __forceinline__ float bf1(bf16_t h) { return __uint_as_float(((unsigned)h) << 16); }
__device__ __forceinline__ float wave_sum(float v) {
#pragma unroll
    for (int o = 1; o < 64; o <<= 1) v += __shfl_xor(v, o);
    return v;
}
__device__ __forceinline__ float ld_ssq(const float* p) { return __hip_atomic_load(p, __ATOMIC_RELAXED, __HIP_MEMORY_SCOPE_AGENT); }
__device__ __forceinline__ int fresh_tid() { int t = threadIdx.x; asm volatile("" : "+v"(t)); return t; }
__device__ __forceinline__ float silu_f(float x) { return x * __builtin_amdgcn_rcpf(1.0f + __expf(-x)); }
__device__ __forceinline__ float sigmoid_f(float x) { return __builtin_amdgcn_rcpf(1.0f + __expf(-x)); }
__device__ __forceinline__ float gelu_tanh(float v) {
    const float z = 0.7978845608f * (v + 0.044715f * v * v * v);
    const float e = __expf(2.0f * z);
    const float th = 1.0f - 2.0f * __builtin_amdgcn_rcpf(e + 1.0f);
    return 0.5f * v * (1.0f + th);
}
template <int CTRL> __device__ __forceinline__ float dppf(float x) { return __int_as_float(__builtin_amdgcn_update_dpp(0, __float_as_int(x), CTRL, 0xf, 0xf, false)); }
template <int CTRL> __device__ __forceinline__ f32x4 dpp4(f32x4 x) { f32x4 r; r.x = dppf<CTRL>(x.x); r.y = dppf<CTRL>(x.y); r.z = dppf<CTRL>(x.z); r.w = dppf<CTRL>(x.w); return r; }
#define WG_BARRIER() do { asm volatile("s_waitcnt vmcnt(0) lgkmcnt(0)" ::: "memory"); __builtin_amdgcn_s_barrier(); asm volatile("" ::: "memory"); } while (0)
#define LDS_BARRIER() do { asm volatile("s_waitcnt lgkmcnt(0)" ::: "memory"); __builtin_amdgcn_s_barrier(); asm volatile("" ::: "memory"); } while (0)

namespace pg8 {
constexpr int BM = 256, BK = 64, HALF = 128, HTB = HALF * BK * 2;
__device__ __forceinline__ int lds_byte(int r, int c) { const int st = (r >> 4) * 2 + (c >> 5), rr = r & 15, cc = c & 31, ob = rr * 64 + cc * 2; return st * 1024 + (ob ^ (((ob >> 9) & 1) << 5)); }
__device__ __forceinline__ void stage_rc(int b, int& R, int& C) { const int st = b / 1024, sb = b % 1024, swz = sb ^ (((sb >> 9) & 1) << 5); R = (st >> 1) * 16 + swz / 64; C = (st & 1) * 32 + (swz % 64) / 2; }

struct Unit { const char* A; const char* B; int row0, col0, aux; };

__device__ __forceinline__ bool tile_order(int i, int G, int c, int nM, int nN, int& pm, int& pn) {
    const int nwg = nM * nN; const long L = (long)i * G + c; if (L >= nwg) return false;
    int wgid = (int)L; { const int q = nwg / 8, r = nwg % 8, xcd = wgid % 8, off = wgid / 8; wgid = (xcd < r ? xcd * (q + 1) : r * (q + 1) + (xcd - r) * q) + off; }
    const int nig = 8 * nN, gid = wgid / nig, fm = gid * 8, gsz = (nM - fm) < 8 ? (nM - fm) : 8;
    pm = fm + ((wgid % nig) % gsz); pn = (wgid % nig) / gsz; return true;
}

template <class Epi, class Sched>
__device__ __forceinline__ void gemm_phase(LAS unsigned char* lds, const int lda, const int ldb, const int K, const Sched& S, const Epi& E) {
    int tid_ = threadIdx.x; asm volatile("" : "+v"(tid_));
    const int tid = tid_, wid = __builtin_amdgcn_readfirstlane(tid >> 6), lane = tid & 63, wr = wid >> 2, wc = wid & 3, fr = lane & 15, fq = lane >> 4;
    const int nt = K / BK;
    unsigned voffA[2], voffB[2];
#pragma unroll
    for (int i = 0; i < 2; ++i) { int R, C; stage_rc(tid * 16 + i * 8192, R, C); voffA[i] = (unsigned)(R * lda + C) * 2u; voffB[i] = (unsigned)(R * ldb + C) * 2u; }
    const size_t kstep = (size_t)(BK * 2);
    const size_t hstepA = (size_t)HALF * lda * 2, hstepB = (size_t)HALF * ldb * 2;
    const unsigned ldsw = (unsigned)wid * 1024u;
    const int aoff = lds_byte(wr * 64 + fr, fq * 8), boff = lds_byte(wc * 32 + fr, fq * 8);
#define PG8_SA(b, h) (((b) * 2 + (h)) * HTB)
#define PG8_SB(b, h) ((4 + (b) * 2 + (h)) * HTB)
#define PG8_STAGE(bufoff, gbase, voff) do { _Pragma("unroll") for (int _i = 0; _i < 2; ++_i) \
        __builtin_amdgcn_global_load_lds((const unsigned*)((const char*)(gbase) + (voff)[_i]), (LAS unsigned*)(lds + (bufoff) + ldsw + _i * 8192), 16, 0, 0); } while (0)
#define PG8_LDA(dst, b, h) do { _Pragma("unroll") for (int m = 0; m < 4; ++m) _Pragma("unroll") for (int k = 0; k < 2; ++k) dst[m][k] = *(const LAS bf16x8*)(lds + PG8_SA(b, h) + aoff + m * 2048 + k * 1024); } while (0)
#define PG8_LDB(dst, b, h) do { _Pragma("unroll") for (int n = 0; n < 2; ++n) _Pragma("unroll") for (int k = 0; k < 2; ++k) dst[n][k] = *(const LAS bf16x8*)(lds + PG8_SB(b, h) + boff + n * 2048 + k * 1024); } while (0)
#define PG8_MMA(ai, bj, At, Bt) do { __builtin_amdgcn_s_setprio(1); _Pragma("unroll") for (int m = 0; m < 4; ++m) _Pragma("unroll") for (int n = 0; n < 2; ++n) _Pragma("unroll") for (int k = 0; k < 2; ++k) \
        acc[ai][bj][m][n] = __builtin_amdgcn_mfma_f32_16x16x32_bf16(Bt[n][k], At[m][k], acc[ai][bj][m][n], 0, 0, 0); __builtin_amdgcn_s_setprio(0); } while (0)
#define PG8_WAIT_V(n) asm volatile("s_waitcnt vmcnt(" #n ")" ::: "memory")
#define PG8_WAIT_L(n) asm volatile("s_waitcnt lgkmcnt(" #n ")" ::: "memory")
#define PG8_BAR __builtin_amdgcn_s_barrier()
#define PG8_SCHED __builtin_amdgcn_sched_barrier(0)
    Unit cur, nxt; int ui = 0;
    if (!S.next(0, cur)) return;
    f32x4 acc[2][2][4][2];
#pragma unroll
    for (int a = 0; a < 2; ++a)
#pragma unroll
        for (int b = 0; b < 2; ++b)
#pragma unroll
            for (int m = 0; m < 4; ++m)
#pragma unroll
                for (int n = 0; n < 2; ++n) acc[a][b][m][n] = (f32x4){0.f, 0.f, 0.f, 0.f};
    bf16x8 At[4][2], B0[2][2], B1[2][2];
    const char* cA = cur.A; const char* cB = cur.B;
    PG8_STAGE(PG8_SB(0, 0), cB, voffB); PG8_STAGE(PG8_SB(0, 1), cB + hstepB, voffB); PG8_STAGE(PG8_SA(0, 0), cA, voffA); PG8_STAGE(PG8_SA(0, 1), cA + hstepA, voffA);
    if (wr == 1) PG8_BAR;
    PG8_WAIT_V(2); PG8_BAR;
    PG8_STAGE(PG8_SB(1, 0), cB + kstep, voffB); PG8_STAGE(PG8_SA(1, 0), cA + kstep, voffA); PG8_STAGE(PG8_SB(1, 1), cB + hstepB + kstep, voffB);
    PG8_WAIT_V(6); PG8_BAR;
    for (;;) {
        const bool has_next = S.next(ui + 1, nxt);
        const char* nA = has_next ? nxt.A : cA; const char* nB = has_next ? nxt.B : cB;
#pragma unroll 1
        for (int t = 0; t < nt; t += 2) {
            const bool last = (t == nt - 2);
            const char* a1 = cA + (size_t)(t + 1) * kstep;
            const char* a2 = last ? nA : cA + (size_t)(t + 2) * kstep; const char* b2 = last ? nB : cB + (size_t)(t + 2) * kstep;
            const char* a3 = a2 + kstep; const char* b3 = b2 + kstep;
            PG8_LDB(B0, 0, 0); PG8_LDB(B1, 0, 1); PG8_SCHED; PG8_LDA(At, 0, 0); PG8_STAGE(PG8_SA(1, 1), a1 + hstepA, voffA);
            PG8_WAIT_V(8); PG8_WAIT_L(0); PG8_BAR; PG8_MMA(0, 0, At, B0); PG8_MMA(0, 1, At, B1); PG8_BAR; PG8_SCHED;
            PG8_LDA(At, 0, 1); PG8_STAGE(PG8_SB(0, 0), b2, voffB); PG8_STAGE(PG8_SB(0, 1), b2 + hstepB, voffB); PG8_STAGE(PG8_SA(0, 0), a2, voffA);
            PG8_WAIT_V(8); PG8_WAIT_L(0); PG8_BAR; PG8_MMA(1, 0, At, B0); PG8_MMA(1, 1, At, B1); PG8_BAR; PG8_SCHED;
            PG8_LDB(B0, 1, 0); PG8_LDB(B1, 1, 1); PG8_SCHED; PG8_LDA(At, 1, 0); PG8_STAGE(PG8_SA(0, 1), a2 + hstepA, voffA);
            PG8_WAIT_V(8); PG8_WAIT_L(0); PG8_BAR; PG8_MMA(0, 0, At, B0); PG8_MMA(0, 1, At, B1); PG8_BAR; PG8_SCHED;
            PG8_LDA(At, 1, 1); PG8_STAGE(PG8_SB(1, 0), b3, voffB); PG8_STAGE(PG8_SB(1, 1), b3 + hstepB, voffB); PG8_STAGE(PG8_SA(1, 0), a3, voffA);
            PG8_WAIT_V(8); PG8_WAIT_L(0); PG8_BAR; PG8_MMA(1, 0, At, B0); PG8_MMA(1, 1, At, B1); PG8_BAR; PG8_SCHED;
        }
        if (wr == 0) PG8_BAR;
        { int efr = fr, efq = fq; asm volatile("" : "+v"(efr), "+v"(efq)); E(acc, cur, wr, wc, efr, efq, lds); }
        if (!has_next) break;
#pragma unroll
        for (int a = 0; a < 2; ++a)
#pragma unroll
            for (int b = 0; b < 2; ++b)
#pragma unroll
                for (int m = 0; m < 4; ++m)
#pragma unroll
                    for (int n = 0; n < 2; ++n) acc[a][b][m][n] = (f32x4){0.f, 0.f, 0.f, 0.f};
        cur = nxt; cA = nA; cB = nB; ++ui;
        if (wr == 1) PG8_BAR;
    }
    PG8_WAIT_V(0);
    PG8_BAR;
#undef PG8_SA
#undef PG8_SB
#undef PG8_STAGE
#undef PG8_LDA
#undef PG8_LDB
#undef PG8_MMA
#undef PG8_WAIT_V
#undef PG8_WAIT_L
#undef PG8_BAR
#undef PG8_SCHED
}

struct SchedPlain {
    const char* A; const char* B; int lda, ldb, nM, nN, G, c, acol, brow;
    __device__ __forceinline__ bool next(int i, Unit& u) const {
        int pm, pn; if (!tile_order(i, G, c, nM, nN, pm, pn)) return false;
        u.A = A + ((size_t)pm * 256 * lda + (size_t)pn * acol) * 2; u.B = B + (size_t)pn * brow * ldb * 2; u.row0 = pm * 256; u.col0 = pn * 256; u.aux = 0; return true;
    }
};
struct SchedAttn {
    const char* A; const char* B; int kind, G, c;
    __device__ __forceinline__ bool next(int i, Unit& u) const {
        const int L = i * G + c; if (L >= 256) return false;
        const int b = L >> 5, h = (L >> 3) & 3, qt = L & 7;
        u.row0 = b * 2048 + qt * 256; u.col0 = h * 256; u.aux = 0;
        u.A = A + ((size_t)u.row0 * 1024 + h * 256) * 2;
        u.B = kind == 0 ? B + ((size_t)(b * 256) * 1024 + h * 256) * 2 : B + ((size_t)(b * 1024 + h * 256) * 256) * 2;
        return true;
    }
};
struct SchedKV {
    const char* memn; const char* wkv; int base, c;
    __device__ __forceinline__ bool next(int i, Unit& u) const {
        if (i != 0 || c < 0 || c >= 64) return false;
        const int L = base + c;
        const int l = L >> 6, kind = (L >> 5) & 1, idx = L & 31; u.aux = l * 2 + kind;
        const char* w = wkv + (size_t)l * 2048 * 1024 * 2;
        if (kind == 0) { const int pm = idx >> 2, pn = idx & 3; u.A = memn + (size_t)pm * 256 * 1024 * 2; u.B = w + (size_t)pn * 256 * 1024 * 2; u.row0 = pm * 256; u.col0 = pn * 256; }
        else { const int b = idx >> 2, pm = idx & 3; u.A = w + (size_t)(1024 + pm * 256) * 1024 * 2; u.B = memn + (size_t)b * 256 * 1024 * 2; u.row0 = b * 1024 + pm * 256; u.col0 = 0; }
        return true;
    }
};

#define EPI_ARGS f32x4 (&acc)[2][2][4][2], const Unit& u, int wr, int wc, int fr, int fq, LAS unsigned char* lds
#define FOR_AI_M _Pragma("unroll") for (int ai = 0; ai < 2; ++ai) _Pragma("unroll") for (int m = 0; m < 4; ++m)
#define FOR_BJ_N _Pragma("unroll") for (int bj = 0; bj < 2; ++bj) _Pragma("unroll") for (int n = 0; n < 2; ++n)
__device__ __forceinline__ void st_bf4(bf16_t* p, f32x4 v) { u32x2 w; w.x = pk2(v.x, v.y); w.y = pk2(v.z, v.w); *(u32x2*)p = w; }

struct EpiWin {
    const float* ssq; bf16_t* qkv; bf16_t* gate; float* ba; bf16_t* uo;
    __device__ __forceinline__ void operator()(EPI_ARGS) const {
        FOR_AI_M { const int row = u.row0 + 128 * ai + 64 * wr + 16 * m + fr; const float rs = rsqrtf(ld_ssq(ssq + row) * (1.0f / 1024.0f) + EPS);
            FOR_BJ_N { const int c = u.col0 + 128 * bj + 32 * wc + 16 * n + 4 * fq; const f32x4 v = acc[ai][bj][m][n] * rs;
                if (c < 1536) st_bf4(qkv + (size_t)row * 1536 + c, v);
                else if (c < 2048) st_bf4(gate + (size_t)row * 512 + (c - 1536), v);
                else if (c < 2056) *(f32x4*)(ba + (size_t)row * 8 + (c - 2048)) = v;
                else if (c < NIN) st_bf4(uo + (size_t)row * 512 + (c - 2056), v); } }
    }
};
struct EpiRes {
    const float* Xin; float* X; bf16_t* XB; float* ssqn; const float* colscale;
    __device__ __forceinline__ void operator()(EPI_ARGS) const {
        FOR_AI_M { const int row = u.row0 + 128 * ai + 64 * wr + 16 * m + fr; float s = 0.f;
            FOR_BJ_N { const int c = u.col0 + 128 * bj + 32 * wc + 16 * n + 4 * fq; f32x4 a = acc[ai][bj][m][n];
                if (colscale) a = a * *(const f32x4*)(colscale + c);
                const f32x4 x = *(const f32x4*)(Xin + (size_t)row * 1024 + c) + a; *(f32x4*)(X + (size_t)row * 1024 + c) = x; if (XB) st_bf4(XB + (size_t)row * 1024 + c, x);
                s += (x.x * x.x + x.y * x.y) + (x.z * x.z + x.w * x.w); }
            s += __shfl_xor(s, 16); s += __shfl_xor(s, 32);
            if (fq == 0) atomicAdd(ssqn + row, s);
            asm volatile("" ::: "memory"); }
    }
};
struct EpiScaleBf {
    const float* ssq; bf16_t* out; int ldc; float scale;
    __device__ __forceinline__ void operator()(EPI_ARGS) const {
        FOR_AI_M { const int row = u.row0 + 128 * ai + 64 * wr + 16 * m + fr; const float rs = (ssq ? rsqrtf(ld_ssq(ssq + row) * (1.0f / 1024.0f) + EPS) : 1.0f) * scale;
            FOR_BJ_N { const int c = u.col0 + 128 * bj + 32 * wc + 16 * n + 4 * fq; st_bf4(out + (size_t)row * ldc + c, acc[ai][bj][m][n] * rs); } }
    }
};
struct EpiKV {
    bf16_t* km; bf16_t* vt;
    __device__ __forceinline__ void operator()(EPI_ARGS) const {
        const int l = u.aux >> 1, kind = u.aux & 1; bf16_t* o = kind == 0 ? km + (size_t)l * 2048 * 1024 : vt + (size_t)l * 8192 * 256; const int ldc = kind == 0 ? 1024 : 256;
        FOR_AI_M { const int row = u.row0 + 128 * ai + 64 * wr + 16 * m + fr;
            FOR_BJ_N { const int c = u.col0 + 128 * bj + 32 * wc + 16 * n + 4 * fq; st_bf4(o + (size_t)row * ldc + c, acc[ai][bj][m][n]); } }
    }
};
struct EpiGlu {
    const bf16_t* yg; const float* bias; bf16_t* mixed;
    __device__ __forceinline__ void operator()(EPI_ARGS) const {
        FOR_AI_M { const int row = u.row0 + 128 * ai + 64 * wr + 16 * m + fr;
            FOR_BJ_N { const int c = u.col0 + 128 * bj + 32 * wc + 16 * n + 4 * fq; const f32x4 z = acc[ai][bj][m][n] + *(const f32x4*)(bias + c);
                const u32x2 yw = *(const u32x2*)(yg + (size_t)row * 512 + c); f32x4 o;
                o.x = bflo(yw.x) * sigmoid_f(z.x); o.y = bfhi(yw.x) * sigmoid_f(z.y); o.z = bflo(yw.y) * sigmoid_f(z.z); o.w = bfhi(yw.y) * sigmoid_f(z.w);
                st_bf4(mixed + (size_t)row * 1024 + 512 + c, o); } }
    }
};
struct EpiSoftmax {
    bf16_t* P;
    __device__ __forceinline__ void operator()(EPI_ARGS) const {
        LAS float* smax = (LAS float*)(lds + LDS_SCR); LAS float* ssum = smax + 1024;
        FOR_AI_M { const int rl = 128 * ai + 64 * wr + 16 * m + fr; float mx = -3.0e38f;
            FOR_BJ_N { const f32x4 v = acc[ai][bj][m][n]; mx = fmaxf(mx, fmaxf(fmaxf(v.x, v.y), fmaxf(v.z, v.w))); }
            mx = fmaxf(mx, __shfl_xor(mx, 16)); mx = fmaxf(mx, __shfl_xor(mx, 32));
            if (fq == 0) smax[rl * 4 + wc] = mx; }
        LDS_BARRIER();
        FOR_AI_M { const int rl = 128 * ai + 64 * wr + 16 * m + fr; const f32x4 mm = *(const LAS f32x4*)(smax + rl * 4);
            const float mx = fmaxf(fmaxf(mm.x, mm.y), fmaxf(mm.z, mm.w)); float s = 0.f;
            FOR_BJ_N { f32x4 v = acc[ai][bj][m][n]; v.x = __expf(v.x - mx); v.y = __expf(v.y - mx); v.z = __expf(v.z - mx); v.w = __expf(v.w - mx); acc[ai][bj][m][n] = v; s += (v.x + v.y) + (v.z + v.w); }
            s += __shfl_xor(s, 16); s += __shfl_xor(s, 32);
            if (fq == 0) ssum[rl * 4 + wc] = s; }
        LDS_BARRIER();
        FOR_AI_M { const int rl = 128 * ai + 64 * wr + 16 * m + fr; const int row = u.row0 + rl; const f32x4 ss = *(const LAS f32x4*)(ssum + rl * 4);
            const float inv = 1.0f / ((ss.x + ss.y) + (ss.z + ss.w));
            FOR_BJ_N { const int c = u.col0 + 128 * bj + 32 * wc + 16 * n + 4 * fq; st_bf4(P + (size_t)row * 1024 + c, acc[ai][bj][m][n] * inv); } }
    }
};
struct EpiUp {
    const float* ssq; const float* cw; bf16_t* act; float* halo;
    __device__ __forceinline__ void operator()(EPI_ARGS) const {
        LAS float* hl = (LAS float*)(lds + LDS_SCR);
        const int pm = u.row0 >> 8, pn = u.col0 >> 8;
        FOR_AI_M { const int row = u.row0 + 128 * ai + 64 * wr + 16 * m + fr; const float rs = rsqrtf(ld_ssq(ssq + row) * (1.0f / 1024.0f) + EPS);
            FOR_BJ_N acc[ai][bj][m][n] = acc[ai][bj][m][n] * rs; }
#pragma unroll
        for (int ai = 0; ai < 2; ++ai) { const int strip = 2 * ai + wr;
            if (fr >= 14) { const int rr = fr - 14;
                FOR_BJ_N { const int lc = 128 * bj + 32 * wc + 16 * n + 4 * fq; *(LAS f32x4*)(hl + (strip * 2 + rr) * 256 + lc) = acc[ai][bj][3][n];
                    if (strip == 3) *(f32x4*)(halo + (size_t)(pm * 4 + 2 + rr) * FF2 + u.col0 + lc) = acc[ai][bj][3][n]; } }
            if (strip == 0 && fr < 2) { FOR_BJ_N { const int lc = 128 * bj + 32 * wc + 16 * n + 4 * fq; *(f32x4*)(halo + (size_t)(pm * 4 + fr) * FF2 + u.col0 + lc) = acc[ai][bj][0][n]; } } }
        LDS_BARRIER();
#pragma unroll
        for (int ai = 0; ai < 2; ++ai) { const int strip = 2 * ai + wr;
#pragma unroll
            for (int n = 0; n < 2; ++n) {
                const int lcg = 32 * wc + 16 * n + 4 * fq; const int ch = pn * 128 + lcg;
                const f32x4 wg0 = *(const f32x4*)(cw + ch), wg1 = *(const f32x4*)(cw + FF2 + ch), wg2 = *(const f32x4*)(cw + 2 * FF2 + ch);
                const f32x4 wv0 = *(const f32x4*)(cw + FF + ch), wv1 = *(const f32x4*)(cw + FF2 + FF + ch), wv2 = *(const f32x4*)(cw + 2 * FF2 + FF + ch);
                f32x4 hg1 = (f32x4){0.f, 0.f, 0.f, 0.f}, hg2 = hg1, hv1 = hg1, hv2 = hg1;
                if (strip > 0) { const LAS float* hp = hl + (strip - 1) * 512 + lcg; hg2 = *(const LAS f32x4*)hp; hg1 = *(const LAS f32x4*)(hp + 256); hv2 = *(const LAS f32x4*)(hp + 128); hv1 = *(const LAS f32x4*)(hp + 384); }
                f32x4 pg1 = hg1, pv1 = hv1, pg2 = (fr == 1) ? hg1 : hg2, pv2 = (fr == 1) ? hv1 : hv2;
#pragma unroll
                for (int m = 0; m < 4; ++m) {
                    const f32x4 g = acc[ai][0][m][n], v = acc[ai][1][m][n];
                    const f32x4 rg1 = dpp4<0x121>(g), rg2 = dpp4<0x122>(g), rv1 = dpp4<0x121>(v), rv2 = dpp4<0x122>(v);
                    const f32x4 g1 = fr >= 1 ? rg1 : pg1, g2 = fr >= 2 ? rg2 : pg2, v1 = fr >= 1 ? rv1 : pv1, v2 = fr >= 2 ? rv2 : pv2;
                    const f32x4 cg_ = wg2 * g + wg1 * g1 + wg0 * g2, cv_ = wv2 * v + wv1 * v1 + wv0 * v2;
                    f32x4 o; o.x = silu_f(cg_.x) * cv_.x; o.y = silu_f(cg_.y) * cv_.y; o.z = silu_f(cg_.z) * cv_.z; o.w = silu_f(cg_.w) * cv_.w;
                    const int row = u.row0 + 128 * ai + 64 * wr + 16 * m + fr;
                    st_bf4(act + (size_t)row * FF + ch, o);
                    pg1 = rg1; pg2 = rg2; pv1 = rv1; pv2 = rv2;
                } } }
    }
};
}

__device__ __forceinline__ void transpose_item(const float* W, int K, int N, bf16_t* WT, const float* gain, int mode, LAS float* scr, int item, int lane) {
    const int nblk = (N + 31) / 32, kb = item / nblk, nb = item % nblk, k0 = 64 * kb, n0 = 32 * nb;
    const int nn = n0 + (lane & 31); const bool inb = nn < N;
    const float* src = W + (size_t)(k0 + (lane >> 5)) * N + (inb ? nn : N - 1);
    float v[32];
#pragma unroll
    for (int i = 0; i < 32; ++i) v[i] = src[(size_t)(2 * i) * N];
    const int c = lane & 7;
    f32x4 g0 = (f32x4){1.f, 1.f, 1.f, 1.f}, g1 = g0;
    if (gain) { g0 = *(const f32x4*)(gain + k0 + 8 * c); g1 = *(const f32x4*)(gain + k0 + 8 * c + 4); }
#pragma unroll
    for (int i = 0; i < 32; ++i) scr[(2 * i + (lane >> 5)) * 33 + (lane & 31)] = inb ? v[i] : 0.f;
    asm volatile("s_waitcnt lgkmcnt(0)" ::: "memory");
    int rbase = n0;
    if (mode == 1) { const int isv = n0 >= FF ? 1 : 0; const int ch = n0 - isv * FF; rbase = (ch >> 7) * 256 + isv * 128 + (ch & 127); }
#pragma unroll
    for (int j = 0; j < 4; ++j) { const int n = (lane >> 3) + 8 * j; const LAS float* s = scr + (8 * c) * 33 + n;
        u32x4 o; o.x = pk2(s[0 * 33] * g0.x, s[1 * 33] * g0.y); o.y = pk2(s[2 * 33] * g0.z, s[3 * 33] * g0.w); o.z = pk2(s[4 * 33] * g1.x, s[5 * 33] * g1.y); o.w = pk2(s[6 * 33] * g1.z, s[7 * 33] * g1.w);
        *(u32x4*)(WT + (size_t)(rbase + n) * K + k0 + 8 * c) = o; }
    asm volatile("s_waitcnt lgkmcnt(0)" ::: "memory");
}

__device__ __forceinline__ void s5_unit_consts(const Params& p, int g, int lane, float& lbr, float& lbi, f32x4 (&frag)[8]);
__device__ __forceinline__ void phase_prologue(const Params& p, LAS unsigned char* lds, int G) {
    const int tid = fresh_tid(), lane = tid & 63, wave = tid >> 6;
    LAS float* scr = (LAS float*)(lds + wave * 16384);
    const int gw = blockIdx.x * 8 + wave, NGW = G * 8;
    unsigned char* ws = p.ws;
    constexpr int NI0 = 16 * 81, NI1 = 8 * 16, NI2 = 16 * 32, NI3 = 16 * 32, NI5 = 16 * 64, NI9 = 16 * 176, NI11 = 44 * 32, NI13 = 4 * 8;
    constexpr int C1 = NI0, C2 = C1 + NI1, C3 = C2 + NI2, C4 = C3 + NI3, C5 = C4 + NI3, C6 = C5 + NI5, C7 = C6 + NI5, C8 = C7 + NI3, C9 = C8 + NI3, C10 = C9 + NI9, C11 = C10 + NI9, C12 = C11 + NI11, C13 = C12 + NI11, CEND = C13 + 4 * NI13;
    for (int gi = gw; gi < CEND; gi += NGW) {
        const float* W; int K, N, mode = 0, it; bf16_t* WT; const float* gain = nullptr;
        if (gi < C1) { it = gi; W = p.in[7]; K = 1024; N = NIN; WT = (bf16_t*)(ws + O_WIN); gain = p.in[2]; }
        else if (gi < C2) { it = gi - C1; W = p.in[20]; K = 512; N = 512; WT = (bf16_t*)(ws + O_WGLU); }
        else if (gi < C3) { it = gi - C2; W = p.in[22]; K = 1024; N = 1024; WT = (bf16_t*)(ws + O_WOUT); }
        else if (gi < C5) { const int l = gi >= C4; it = gi - (l ? C4 : C3); W = p.in[25] + l * 1048576; K = 1024; N = 1024; WT = (bf16_t*)(ws + O_WQ) + l * 1048576; gain = p.in[3] + l * 1024; }
        else if (gi < C7) { const int l = gi >= C6; it = gi - (l ? C6 : C5); W = p.in[26] + l * 2097152; K = 1024; N = 2048; WT = (bf16_t*)(ws + O_WKV) + l * 2097152; }
        else if (gi < C9) { const int l = gi >= C8; it = gi - (l ? C8 : C7); W = p.in[27] + l * 1048576; K = 1024; N = 1024; WT = (bf16_t*)(ws + O_WO) + l * 1048576; }
        else if (gi < C11) { const int l = gi >= C10; it = gi - (l ? C10 : C9); W = p.in[28] + (size_t)l * 1024 * FF2; K = 1024; N = FF2; WT = (bf16_t*)(ws + O_WUP) + (size_t)l * FF2 * 1024; gain = p.in[4] + l * 1024; mode = 1; }
        else if (gi < C13) { const int l = gi >= C12; it = gi - (l ? C12 : C11); W = p.in[30] + (size_t)l * FF * 1024; K = FF; N = 1024; WT = (bf16_t*)(ws + O_WDN) + (size_t)l * 1024 * FF; }
        else { const int q = (gi - C13) / NI13; it = gi - C13 - q * NI13; W = p.in[23] + q * 65536; K = 256; N = 256; WT = (bf16_t*)(ws + O_POOL) + q * 65536; }
        transpose_item(W, K, N, WT, gain, mode, scr, it, lane);
    }
    { u32x4* z = (u32x4*)((bf16_t*)(ws + O_WIN) + (size_t)2592 * 1024); const int n16 = 224 * 1024 * 2 / 16;
      for (int i = blockIdx.x * 512 + tid; i < n16; i += G * 512) z[i] = (u32x4){0u, 0u, 0u, 0u}; }
    { float* s = (float*)(ws + O_SSQ) + MT; for (int i = blockIdx.x * 512 + tid; i < 6 * MT; i += G * 512) __hip_atomic_store(s + i, 0.f, __ATOMIC_RELAXED, __HIP_MEMORY_SCOPE_AGENT); }
    for (int g = gw; g < 32; g += NGW) {
        float lbr, lbi; f32x4 frag[8]; s5_unit_consts(p, g, lane, lbr, lbi, frag);
        f32x4* tf = (f32x4*)(ws + O_XPREV) + (size_t)g * 512 + lane;
#pragma unroll
        for (int k = 0; k < 8; ++k) tf[64 * k] = frag[k];
        float* tl = (float*)(ws + O_XPREV + 262144) + ((size_t)g * 64 + lane) * 2; tl[0] = lbr; tl[1] = lbi;
    }
    for (int r = gw; r < 2048; r += NGW) {
        const f32x4* xr = (const f32x4*)(p.in[1] + (size_t)r * 1024) + lane; const f32x4* gr = (const f32x4*)p.in[5] + lane;
        f32x4 v[4]; float s = 0.f;
#pragma unroll
        for (int j = 0; j < 4; ++j) { v[j] = xr[64 * j]; s += (v[j].x * v[j].x + v[j].y * v[j].y) + (v[j].z * v[j].z + v[j].w * v[j].w); }
        const float rs = rsqrtf(wave_sum(s) * (1.0f / 1024.0f) + EPS);
        bf16_t* o = (bf16_t*)(ws + O_MEMN) + (size_t)r * 1024;
#pragma unroll
        for (int j = 0; j < 4; ++j) pg8::st_bf4(o + (64 * j + lane) * 4, v[j] * rs * gr[64 * j]);
    }
    for (int r = gw; r < MT; r += NGW) {
        const f32x4* xr = (const f32x4*)(p.in[0] + (size_t)r * 1024) + lane;
        bf16_t* o = (bf16_t*)(ws + O_XB) + (size_t)r * 1024; float s = 0.f;
#pragma unroll
        for (int j = 0; j < 4; ++j) { const f32x4 v = xr[64 * j]; pg8::st_bf4(o + (64 * j + lane) * 4, v); s += (v.x * v.x + v.y * v.y) + (v.z * v.z + v.w * v.w); }
        s = wave_sum(s); if (lane == 0) ((float*)(ws + O_SSQ))[r] = s;
    }
}

__device__ __forceinline__ void delta_prep(const Params& p, LAS unsigned char* lds, int chunk) {
    const int tid = fresh_tid(), lane = tid & 63, wave = tid >> 6;
    const int c = chunk & 31, bh = chunk >> 5, h = bh & 3, b = bh >> 2;
    const int row0 = b * SEQ + c * 64;
    LAS float* qf = (LAS float*)lds;
    LAS float* kf = qf + 64 * 132;
    LAS float* vf = kf + 64 * 132;
    LAS float* Am = vf + 64 * 132;
    LAS float* gc = Am + 64 * 68;
    LAS float* bt = gc + 64;
    LAS float* Tinv = bt + 64;
    unsigned char* ws = p.ws;
    const bf16_t* raw = (const bf16_t*)(ws + O_QKVRAW);
    if (tid < 384) {
        const int quad = tid % 96, seg = tid / 96, part = quad >> 5, within = (quad & 31) * 4, gcol = part * 512 + h * 128 + within;
        const float* cwp = p.in[8] + gcol;
        const f32x4 w0 = *(const f32x4*)cwp, w1 = *(const f32x4*)(cwp + 1536), w2 = *(const f32x4*)(cwp + 3072), w3 = *(const f32x4*)(cwp + 4608);
        LAS float* dst = (part == 0 ? qf : (part == 1 ? kf : vf)) + within;
        const int t0 = seg * 16;
        u32x2 rw[19];
#pragma unroll
        for (int k = 0; k < 19; ++k) { const int t = t0 - 3 + k; const int tc = (c * 64 + t >= 0) ? t : 0; rw[k] = *(const u32x2*)(raw + (size_t)(row0 + tc) * 1536 + gcol); }
        f32x4 xs[19];
#pragma unroll
        for (int k = 0; k < 19; ++k) { const bool ok = (c * 64 + t0 - 3 + k >= 0); xs[k] = ok ? (f32x4){bflo(rw[k].x), bfhi(rw[k].x), bflo(rw[k].y), bfhi(rw[k].y)} : (f32x4){0.f, 0.f, 0.f, 0.f}; }
#pragma unroll
        for (int i = 0; i < 16; ++i) {
            const f32x4 y = w0 * xs[i] + w1 * xs[i + 1] + w2 * xs[i + 2] + w3 * xs[i + 3];
            f32x4 o; o.x = silu_f(y.x); o.y = silu_f(y.y); o.z = silu_f(y.z); o.w = silu_f(y.w);
            *(LAS f32x4*)(dst + (t0 + i) * 132) = o;
        }
    } else if (wave == 6) {
        const float* ba = (const float*)(ws + O_BA) + (size_t)(row0 + lane) * 8;
        const float al = ba[4 + h] + p.in[10][h]; const float sp = al > 20.f ? al : log1pf(expf(al));
        float g = -expf(p.in[9][h]) * sp;
#pragma unroll
        for (int o = 1; o < 64; o <<= 1) { const float t = __shfl_up(g, o); if (lane >= o) g += t; }
        gc[lane] = g; bt[lane] = sigmoid_f(ba[h]);
        if (lane == 63) ((float*)(ws + O_GL))[chunk] = expf(g);
    }
    LDS_BARRIER();
    {
        const int r = tid >> 2, qr = tid & 3; LAS float* rp = (r < 64 ? qf + r * 132 : kf + (r - 64) * 132) + qr * 32;
        f32x4 v[8]; float s = 0.f;
#pragma unroll
        for (int j = 0; j < 8; ++j) { v[j] = *(const LAS f32x4*)(rp + 4 * j); s += (v[j].x * v[j].x + v[j].y * v[j].y) + (v[j].z * v[j].z + v[j].w * v[j].w); }
        s += __shfl_xor(s, 1); s += __shfl_xor(s, 2);
        const float sc = rsqrtf(s + 1e-6f) * (r < 64 ? 0.08838834764831845f : 1.0f);
#pragma unroll
        for (int j = 0; j < 8; ++j) *(LAS f32x4*)(rp + 4 * j) = v[j] * sc;
    }
    LDS_BARRIER();
    bf16_t* dp2 = (bf16_t*)(ws + O_DP2 + (size_t)chunk * 40960);
    bf16_t* dp1 = (bf16_t*)(ws + O_DP1 + (size_t)chunk * 32768);
    for (int job = wave; job < 32; job += 8) {
        const int isqk = job >> 4, ti = (job >> 2) & 3, tj = job & 3;
        const int fr = lane & 15, fq = lane >> 4;
        const LAS float* ap = (isqk ? qf : kf) + (16 * ti + fr) * 132 + fq;
        const LAS float* bp = kf + (16 * tj + fr) * 132 + fq;
        f32x4 acc = (f32x4){0.f, 0.f, 0.f, 0.f}, acc1 = acc;
#pragma unroll 8
        for (int ks = 0; ks < 32; ks += 2) { acc = __builtin_amdgcn_mfma_f32_16x16x4f32(ap[4 * ks], bp[4 * ks], acc, 0, 0, 0); acc1 = __builtin_amdgcn_mfma_f32_16x16x4f32(ap[4 * ks + 4], bp[4 * ks + 4], acc1, 0, 0, 0); }
        acc = acc + acc1;
        const int j = 16 * tj + fr; const float gj = gc[j];
#pragma unroll
        for (int r = 0; r < 4; ++r) { const int i = 16 * ti + 4 * fq + r; const float dec = __expf(gc[i] - gj);
            if (!isqk) { Am[i * 68 + j] = (j < i) ? acc[r] * dec * bt[i] : 0.f; }
            else { const float v = (j <= i) ? acc[r] * dec : 0.f;
                const int mt = i >> 4, ii = i & 15, ks2 = j >> 5, r32 = j & 31, jj = 4 * (r32 >> 4) + (r32 & 3), q = (r32 & 15) >> 2;
                dp2[16384 + ((mt * 2 + ks2) * 64 + ii + 16 * q) * 8 + jj] = (bf16_t)f2bf(v); } }
    }
    LDS_BARRIER();
    if (wave == 0) {
        const int b = lane >> 4, j = lane & 15; float t[16];
#pragma unroll
        for (int i = 0; i < 16; ++i) {
            const LAS f32x4* ar = (const LAS f32x4*)(Am + (16 * b + i) * 68 + 16 * b);
            float sacc = (i == j) ? 1.f : 0.f;
#pragma unroll
            for (int k4 = 0; k4 < (i + 3) / 4; ++k4) { const f32x4 a = ar[k4];
                if (4 * k4 + 0 < i) sacc -= a.x * t[4 * k4 + 0]; if (4 * k4 + 1 < i) sacc -= a.y * t[4 * k4 + 1];
                if (4 * k4 + 2 < i) sacc -= a.z * t[4 * k4 + 2]; if (4 * k4 + 3 < i) sacc -= a.w * t[4 * k4 + 3]; }
            t[i] = sacc; Tinv[(b * 16 + i) * 16 + j] = sacc;
        }
    } else {
        const float gl = gc[63];
#pragma unroll 1
        for (int f = tid - 64; f < 1024; f += 448) {
            const int ln = f & 63, ii = ln & 15, q = ln >> 4;
            {
                const int mt = f >> 8, ks = (f >> 6) & 3, i = 16 * mt + ii; const float e = __expf(gc[i]);
                const LAS float* sp = qf + i * 132 + 32 * ks + 4 * q; const f32x4 lo = *(const LAS f32x4*)sp, hi = *(const LAS f32x4*)(sp + 16);
                u32x4 o; o.x = pk2(lo.x * e, lo.y * e); o.y = pk2(lo.z * e, lo.w * e); o.z = pk2(hi.x * e, hi.y * e); o.w = pk2(hi.z * e, hi.w * e);
                *(u32x4*)(dp2 + (size_t)f * 8) = o; }
            {
                const int mt8 = f >> 7, ks2 = (f >> 6) & 1, dk = 16 * mt8 + ii; float v[8];
#pragma unroll
                for (int jj = 0; jj < 8; ++jj) { const int sidx = 32 * ks2 + 16 * (jj >> 2) + 4 * q + (jj & 3); v[jj] = kf[sidx * 132 + dk] * __expf(gl - gc[sidx]); }
                u32x4 o; o.x = pk2(v[0], v[1]); o.y = pk2(v[2], v[3]); o.z = pk2(v[4], v[5]); o.w = pk2(v[6], v[7]);
                *(u32x4*)(dp2 + 8192 + (size_t)f * 8) = o; }
        }
    }
    LDS_BARRIER();
    {
        const int fr = lane & 15, fq = lane >> 4;
#pragma unroll 1
        for (int nt2 = 0; nt2 < 2; ++nt2) {
            const int col = 32 * wave + 16 * nt2 + fr; const bool isw = wave >= 4;
            LAS float* buf = isw ? kf + (col - 128) : vf + col;
            f32x4 X[4];
#pragma unroll
            for (int b = 0; b < 4; ++b) {
                f32x4 acc = (f32x4){0.f, 0.f, 0.f, 0.f};
#pragma unroll
                for (int b2 = 0; b2 < b; ++b2) { const f32x4 a = *(const LAS f32x4*)(Am + (16 * b + fr) * 68 + 16 * b2 + 4 * fq);
                    acc = __builtin_amdgcn_mfma_f32_16x16x4f32(a.x, X[b2].x, acc, 0, 0, 0); acc = __builtin_amdgcn_mfma_f32_16x16x4f32(a.y, X[b2].y, acc, 0, 0, 0);
                    acc = __builtin_amdgcn_mfma_f32_16x16x4f32(a.z, X[b2].z, acc, 0, 0, 0); acc = __builtin_amdgcn_mfma_f32_16x16x4f32(a.w, X[b2].w, acc, 0, 0, 0); }
                f32x4 R;
#pragma unroll
                for (int r = 0; r < 4; ++r) { const int row = 16 * b + 4 * fq + r; float v = buf[row * 132] * bt[row]; if (isw) v *= __expf(gc[row]); R[r] = v - acc[r]; }
                const f32x4 tv = *(const LAS f32x4*)(Tinv + (b * 16 + fr) * 16 + 4 * fq);
                f32x4 xb = (f32x4){0.f, 0.f, 0.f, 0.f};
                xb = __builtin_amdgcn_mfma_f32_16x16x4f32(tv.x, R.x, xb, 0, 0, 0); xb = __builtin_amdgcn_mfma_f32_16x16x4f32(tv.y, R.y, xb, 0, 0, 0);
                xb = __builtin_amdgcn_mfma_f32_16x16x4f32(tv.z, R.z, xb, 0, 0, 0); xb = __builtin_amdgcn_mfma_f32_16x16x4f32(tv.w, R.w, xb, 0, 0, 0);
                X[b] = xb;
#pragma unroll
                for (int r = 0; r < 4; ++r) buf[(16 * b + 4 * fq + r) * 132] = xb[r];
            }
        }
    }
    LDS_BARRIER();
#pragma unroll 1
    for (int f = tid; f < 1024; f += 512) {
        { const int i = f >> 4, c8 = (f & 15) * 8; const LAS float* s = vf + i * 132 + c8; const f32x4 lo = *(const LAS f32x4*)s, hi = *(const LAS f32x4*)(s + 4);
          u32x4 o; o.x = pk2(lo.x, lo.y); o.y = pk2(lo.z, lo.w); o.z = pk2(hi.x, hi.y); o.w = pk2(hi.z, hi.w);
          *(u32x4*)(dp1 + 8192 + i * 128 + c8) = o; }
        { const int ln = f & 63, ii = ln & 15, q = ln >> 4, mt = f >> 8, ks = (f >> 6) & 3, i = 16 * mt + ii;
          const LAS float* s = kf + i * 132 + 32 * ks + 4 * q; const f32x4 lo = *(const LAS f32x4*)s, hi = *(const LAS f32x4*)(s + 16);
          u32x4 o; o.x = pk2(lo.x, lo.y); o.y = pk2(lo.z, lo.w); o.z = pk2(hi.x, hi.y); o.w = pk2(hi.z, hi.w);
          *(u32x4*)(dp1 + (size_t)f * 8) = o; }
    }
    LDS_BARRIER();
}

constexpr int SCAN_BUF = 59392;
__device__ __forceinline__ void scan_compute(LAS unsigned char* cur, f32x4 (&S)[8], float gl, float* orow, int lane) {
    const int fr = lane & 15, fq = lane >> 4;
    const LAS bf16x8* wf = (const LAS bf16x8*)cur + lane; const LAS bf16x8* qg = wf + 1024; const LAS bf16x8* kd = wf + 2048; const LAS bf16x8* qk = wf + 3072;
    const LAS bf16_t* uu = (const LAS bf16_t*)(cur + 57344);
    bf16x8 bS[4];
#pragma unroll
    for (int ks = 0; ks < 4; ++ks) { u32x4 w; w.x = pk2(S[2 * ks].x, S[2 * ks].y); w.y = pk2(S[2 * ks].z, S[2 * ks].w); w.z = pk2(S[2 * ks + 1].x, S[2 * ks + 1].y); w.w = pk2(S[2 * ks + 1].z, S[2 * ks + 1].w); bS[ks] = __builtin_bit_cast(bf16x8, w); }
    f32x4 vn[4], o[4];
#pragma unroll
    for (int mt = 0; mt < 4; ++mt) {
        f32x4 a = (f32x4){0.f, 0.f, 0.f, 0.f}, q = a;
#pragma unroll
        for (int ks = 0; ks < 4; ++ks) { a = __builtin_amdgcn_mfma_f32_16x16x32_bf16(wf[(mt * 4 + ks) * 64], bS[ks], a, 0, 0, 0); q = __builtin_amdgcn_mfma_f32_16x16x32_bf16(qg[(mt * 4 + ks) * 64], bS[ks], q, 0, 0, 0); }
        f32x4 uv;
#pragma unroll
        for (int r = 0; r < 4; ++r) uv[r] = bf1(uu[(16 * mt + 4 * fq + r) * 16 + fr]);
        vn[mt] = uv - a; o[mt] = q;
        __builtin_amdgcn_sched_barrier(0);
    }
    __builtin_amdgcn_sched_barrier(0);
    bf16x8 bV[2];
#pragma unroll
    for (int ks = 0; ks < 2; ++ks) { u32x4 w; w.x = pk2(vn[2 * ks].x, vn[2 * ks].y); w.y = pk2(vn[2 * ks].z, vn[2 * ks].w); w.z = pk2(vn[2 * ks + 1].x, vn[2 * ks + 1].y); w.w = pk2(vn[2 * ks + 1].z, vn[2 * ks + 1].w); bV[ks] = __builtin_bit_cast(bf16x8, w); }
#pragma unroll
    for (int m8 = 0; m8 < 8; ++m8) {
        f32x4 sv = S[m8] * gl;
#pragma unroll
        for (int ks = 0; ks < 2; ++ks) sv = __builtin_amdgcn_mfma_f32_16x16x32_bf16(kd[(m8 * 2 + ks) * 64], bV[ks], sv, 0, 0, 0);
        S[m8] = sv;
        if (m8 & 1) __builtin_amdgcn_sched_barrier(0);
    }
    __builtin_amdgcn_sched_barrier(0);
#pragma unroll
    for (int mt = 0; mt < 4; ++mt) {
#pragma unroll
        for (int ks = 0; ks < 2; ++ks) o[mt] = __builtin_amdgcn_mfma_f32_16x16x32_bf16(qk[(mt * 2 + ks) * 64], bV[ks], o[mt], 0, 0, 0);
#pragma unroll
        for (int r = 0; r < 4; ++r) orow[(size_t)(16 * mt + 4 * fq + r) * 512 + fr] = o[mt][r];
    }
}
__device__ __forceinline__ void s5_unit_consts(const Params& p, int g, int lane, float& lbr, float& lbi, f32x4 (&frag)[8]) {
    const int fr = lane & 15, fq = lane >> 4;
    const float dt = expf(p.in[19][g]); const float lr = p.in[12][g * 64 + lane], li = p.in[13][g * 64 + lane];
    const float mag = expf(lr * dt); float sn, cs; sincosf(li * dt, &sn, &cs); lbr = mag * cs; lbi = mag * sn;
    const float den = lr * lr + li * li, nr = lbr - 1.0f, ni = lbi; const float cr = (nr * lr + ni * li) / den, ci = (ni * lr - nr * li) / den;
    const float msk = fq < 2 ? 1.0f : 0.0f;
#pragma unroll
    for (int m4 = 0; m4 < 4; ++m4) {
        const int pm = 16 * m4 + fr; const float crs = __shfl(cr, pm) * msk, cis = __shfl(ci, pm) * msk;
        const float* brp = p.in[14] + (size_t)(g * 64 + pm) * 16 + 8 * (fq & 1); const float* bip = p.in[15] + (size_t)(g * 64 + pm) * 16 + 8 * (fq & 1);
        const f32x4 b0 = *(const f32x4*)brp, b1 = *(const f32x4*)(brp + 4), i0 = *(const f32x4*)bip, i1 = *(const f32x4*)(bip + 4);
        const f32x4 r0 = b0 * crs - i0 * cis, r1 = b1 * crs - i1 * cis, m0 = i0 * crs + b0 * cis, m1 = i1 * crs + b1 * cis;
        u32x4 wr_, wi_; wr_.x = pk2(r0.x, r0.y); wr_.y = pk2(r0.z, r0.w); wr_.z = pk2(r1.x, r1.y); wr_.w = pk2(r1.z, r1.w);
        wi_.x = pk2(m0.x, m0.y); wi_.y = pk2(m0.z, m0.w); wi_.z = pk2(m1.x, m1.y); wi_.w = pk2(m1.z, m1.w);
        frag[m4] = __builtin_bit_cast(f32x4, wr_); frag[m4 + 4] = __builtin_bit_cast(f32x4, wi_);
        asm volatile("" ::: "memory");
    }
}
constexpr int XSB_STRIDE = 136, XSB_BYTES = 16 * XSB_STRIDE * 2;
__device__ __forceinline__ u32x4 s5_u_load(const bf16_t* ub, int row16, int g, int lane) { return *(const u32x4*)(ub + (size_t)(row16 + (lane & 15)) * 512 + g * 16 + 8 * ((lane >> 4) & 1)); }
__device__ __forceinline__ void s5_bu_tile(u32x4 uf, int lane, const f32x4 (&frag)[8], LAS bf16_t* XSb) {
    const int fr = lane & 15, fq = lane >> 4;
    if (fq >= 2) uf = (u32x4){0u, 0u, 0u, 0u};
    const bf16x8 ufr = __builtin_bit_cast(bf16x8, uf);
#pragma unroll
    for (int mt = 0; mt < 8; ++mt) {
        const f32x4 a = __builtin_amdgcn_mfma_f32_16x16x32_bf16(__builtin_bit_cast(bf16x8, frag[mt]), ufr, (f32x4){0.f, 0.f, 0.f, 0.f}, 0, 0, 0);
        u32x2 w; w.x = pk2(a[0], a[1]); w.y = pk2(a[2], a[3]);
        *(LAS u32x2*)(XSb + fr * XSB_STRIDE + 16 * mt + 4 * fq) = w;
    }
    asm volatile("s_waitcnt lgkmcnt(0)" ::: "memory");
}
__device__ __forceinline__ void s5_consts(const Params& p, int g, int lane, float& lbr, float& lbi, float (&bbr)[16], float (&bbi)[16]);
#define S5_STEP(t) do { float bur = 0.f, bui = 0.f; \
    _Pragma("unroll") for (int k = 0; k < 8; ++k) { const unsigned w = (unsigned)__builtin_amdgcn_readlane((int)ur[k], (t)); const float u0 = bflo(w), u1 = bfhi(w); \
        bur += bbr[2 * k] * u0; bui += bbi[2 * k] * u0; bur += bbr[2 * k + 1] * u1; bui += bbi[2 * k + 1] * u1; } \
    const float nxr = lbr * xr - lbi * xi + bur, nxi = lbr * xi + lbi * xr + bui; xr = nxr; xi = nxi; } while (0)
__device__ __forceinline__ void delta_scan(const Params& p, LAS unsigned char* lds, int item, int G) {
    const int tid = fresh_tid(), lane = tid & 63, wave = __builtin_amdgcn_readfirstlane(tid >> 6), fr = lane & 15, fq = lane >> 4;
    const int bh = item >> 3, sl = item & 7, h = bh & 3, b = bh >> 2;
    unsigned char* ws = p.ws;
    float* od = (float*)(ws + O_ODELTA) + (size_t)(b * SEQ) * 512 + h * 128 + 16 * sl;
    const float* glp = (const float*)(ws + O_GL) + bh * 32;
#define SCAN_STAGE(c_, bufp_) do { const int chunk_ = bh * 32 + (c_); \
        const char* s1_ = (const char*)(ws + O_DP1 + (size_t)chunk_ * 32768) + (size_t)tid * 16; const char* s2_ = (const char*)(ws + O_DP2 + (size_t)chunk_ * 40960) + (size_t)tid * 16; \
        LAS unsigned char* d_ = (bufp_) + wave * 1024; \
        __builtin_amdgcn_global_load_lds((const unsigned*)s1_, (LAS unsigned*)d_, 16, 0, 0); \
        __builtin_amdgcn_global_load_lds((const unsigned*)(s1_ + 8192), (LAS unsigned*)(d_ + 8192), 16, 0, 0); \
        _Pragma("unroll") for (int k_ = 0; k_ < 5; ++k_) __builtin_amdgcn_global_load_lds((const unsigned*)(s2_ + 8192 * k_), (LAS unsigned*)(d_ + 16384 + 8192 * k_), 16, 0, 0); \
        if (wave < 2) __builtin_amdgcn_global_load_lds((const unsigned*)(ws + O_DP1 + (size_t)chunk_ * 32768 + 16384 + (size_t)(tid >> 1) * 256 + sl * 32 + (tid & 1) * 16), (LAS unsigned*)(d_ + 57344), 16, 0, 0); } while (0)
    int s5_un = item * 7 + (wave - 1); const int s5_stride = G * 7; int s5_sc = 0;
    float lbr = 0.f, lbi = 0.f, xr = 0.f, xi = 0.f;
    f32x4 S[8];
    int s5_rowb = 0, s5_g = 0;
    LAS bf16_t* XSb = (LAS bf16_t*)(lds + 2 * SCAN_BUF + (wave > 0 ? wave - 1 : 0) * XSB_BYTES);
    const bf16_t* ub = (const bf16_t*)(ws + O_U); bf16_t* yg = (bf16_t*)(ws + O_YG);
#define S5_SUB() do { if (s5_un < 8192) { \
        if (s5_sc == 0) { const int c_ = s5_un & 31; s5_g = (s5_un >> 5) & 31; const int b_ = s5_un >> 10; s5_rowb = b_ * SEQ + c_ * 64; \
            { const f32x4* tf_ = (const f32x4*)(ws + O_XPREV) + (size_t)s5_g * 512 + lane; _Pragma("unroll") for (int k_ = 0; k_ < 8; ++k_) S[k_] = tf_[64 * k_]; \
              const float* tl_ = (const float*)(ws + O_XPREV + 262144) + ((size_t)s5_g * 64 + lane) * 2; lbr = tl_[0]; lbi = tl_[1]; } \
            xr = 0.f; xi = 0.f; \
            { float ar_ = lbr, ai_ = lbi; \
              _Pragma("unroll") for (int k_ = 0; k_ < 6; ++k_) { const float nr_ = ar_ * ar_ - ai_ * ai_, ni_ = 2.0f * ar_ * ai_; ar_ = nr_; ai_ = ni_; } \
              const float* xe_ = (const float*)(ws + O_XEND) + ((size_t)(s5_un - c_) * 64 + lane) * 2; \
              float er_[31], ei_[31]; \
              _Pragma("unroll") for (int k_ = 0; k_ < 31; ++k_) { const int cc_ = k_ < c_ ? k_ : 0; const float2 e_ = *(const float2*)(xe_ + cc_ * 128); er_[k_] = e_.x; ei_[k_] = e_.y; } \
              _Pragma("unroll") for (int k_ = 0; k_ < 31; ++k_) { if (k_ < c_) { const float nr_ = ar_ * xr - ai_ * xi + er_[k_], ni_ = ar_ * xi + ai_ * xr + ei_[k_]; xr = nr_; xi = ni_; } } } \
        } \
        const int row_ = s5_rowb + s5_sc * 16 + fr; \
        const u32x2 uw_ = *(const u32x2*)(ub + (size_t)row_ * 512 + s5_g * 16 + 4 * fq); \
        bf16x8 ccf[4]; f32x4 dd; \
        _Pragma("unroll") for (int ks_ = 0; ks_ < 4; ++ks_) { const float* cp_ = (ks_ < 2 ? p.in[16] : p.in[17]) + (size_t)(s5_g * 16 + fr) * 64 + (32 * ks_ & 63) + 8 * fq; \
            const f32x4 lo_ = *(const f32x4*)cp_, hi_ = *(const f32x4*)(cp_ + 4); const float sg_ = ks_ < 2 ? 1.f : -1.f; u32x4 w_; \
            w_.x = pk2(lo_.x * sg_, lo_.y * sg_); w_.y = pk2(lo_.z * sg_, lo_.w * sg_); w_.z = pk2(hi_.x * sg_, hi_.y * sg_); w_.w = pk2(hi_.z * sg_, hi_.w * sg_); ccf[ks_] = __builtin_bit_cast(bf16x8, w_); } \
        dd = *(const f32x4*)(p.in[18] + s5_g * 16 + 4 * fq); \
        s5_bu_tile(s5_u_load(ub, s5_rowb + s5_sc * 16, s5_g, lane), lane, S, XSb); \
        _Pragma("unroll 4") for (int t16_ = 0; t16_ < 16; ++t16_) { const float bur_ = bf1(XSb[t16_ * XSB_STRIDE + lane]), bui_ = bf1(XSb[t16_ * XSB_STRIDE + 64 + lane]); \
            const float nxr_ = lbr * xr - lbi * xi + bur_, nxi_ = lbr * xi + lbi * xr + bui_; xr = nxr_; xi = nxi_; \
            { const unsigned w2_ = pk2(xr, xi); XSb[t16_ * XSB_STRIDE + lane] = (bf16_t)w2_; XSb[t16_ * XSB_STRIDE + 64 + lane] = (bf16_t)(w2_ >> 16); } } \
        asm volatile("s_waitcnt lgkmcnt(0)" ::: "memory"); \
        f32x4 acc_ = (f32x4){0.f, 0.f, 0.f, 0.f}; \
        _Pragma("unroll") for (int ks_ = 0; ks_ < 4; ++ks_) acc_ = __builtin_amdgcn_mfma_f32_16x16x32_bf16(ccf[ks_], *(const LAS bf16x8*)(XSb + fr * XSB_STRIDE + 32 * ks_ + 8 * fq), acc_, 0, 0, 0); \
        f32x4 y_; y_.x = acc_[0] + dd.x * bflo(uw_.x); y_.y = acc_[1] + dd.y * bfhi(uw_.x); y_.z = acc_[2] + dd.z * bflo(uw_.y); y_.w = acc_[3] + dd.w * bfhi(uw_.y); \
        y_.x = gelu_tanh(y_.x); y_.y = gelu_tanh(y_.y); y_.z = gelu_tanh(y_.z); y_.w = gelu_tanh(y_.w); \
        pg8::st_bf4(yg + (size_t)row_ * 512 + s5_g * 16 + 4 * fq, y_); \
        asm volatile("s_waitcnt lgkmcnt(0)" ::: "memory"); \
        if (++s5_sc == 4) { s5_sc = 0; s5_un += s5_stride; } } } while (0)
#pragma unroll
    for (int i = 0; i < 8; ++i) S[i] = (f32x4){0.f, 0.f, 0.f, 0.f};
    SCAN_STAGE(0, lds);
    WG_BARRIER();
#pragma unroll 1
    for (int c = 0; c < 32; ++c) {
        LAS unsigned char* cur = lds + (c & 1) * SCAN_BUF; LAS unsigned char* nxt = lds + ((c + 1) & 1) * SCAN_BUF;
        if (c + 1 < 32) SCAN_STAGE(c + 1, nxt);
        if (wave == 0) scan_compute(cur, S, glp[c], od + (size_t)(c * 64) * 512, lane); else S5_SUB();
        WG_BARRIER();
    }
    if (wave != 0) { while (s5_un < 8192) S5_SUB(); }
#undef SCAN_STAGE
#undef S5_SUB
}

struct S5C { float lbr, lbi; float bbr[16], bbi[16]; };
__device__ __forceinline__ void s5_consts(const Params& p, int g, int lane, float& lbr, float& lbi, float (&bbr)[16], float (&bbi)[16]) {
    const float dt = expf(p.in[19][g]); const float lr = p.in[12][g * 64 + lane], li = p.in[13][g * 64 + lane];
    const float mag = expf(lr * dt); float sn, cs; sincosf(li * dt, &sn, &cs); lbr = mag * cs; lbi = mag * sn;
    const float den = lr * lr + li * li, nr = lbr - 1.0f, ni = lbi; const float cr = (nr * lr + ni * li) / den, ci = (ni * lr - nr * li) / den;
    const f32x4* br4 = (const f32x4*)(p.in[14] + (size_t)(g * 64 + lane) * 16); const f32x4* bi4 = (const f32x4*)(p.in[15] + (size_t)(g * 64 + lane) * 16);
#pragma unroll
    for (int q = 0; q < 4; ++q) { const f32x4 br = br4[q], bi = bi4[q];
#pragma unroll
        for (int k = 0; k < 4; ++k) { bbr[4 * q + k] = cr * br[k] - ci * bi[k]; bbi[4 * q + k] = cr * bi[k] + ci * br[k]; } }
}
__device__ __forceinline__ void s5_pass1(const Params& p, LAS unsigned char* lds, int unit) {
    const int tid2 = fresh_tid(); const int lane = tid2 & 63, wave = tid2 >> 6; const int c = unit & 31, g = (unit >> 5) & 31, b = unit >> 10;
    LAS bf16_t* XSb = (LAS bf16_t*)(lds + wave * XSB_BYTES);
    const bf16_t* ub = (const bf16_t*)(p.ws + O_U); const int rowb = b * SEQ + c * 64;
    u32x4 uf[4];
#pragma unroll
    for (int sc = 0; sc < 4; ++sc) uf[sc] = s5_u_load(ub, rowb + sc * 16, g, lane);
    float lbr, lbi; f32x4 frag[8];
    { const f32x4* tf = (const f32x4*)(p.ws + O_XPREV) + (size_t)g * 512 + lane;
#pragma unroll
      for (int k = 0; k < 8; ++k) frag[k] = tf[64 * k];
      const float* tl = (const float*)(p.ws + O_XPREV + 262144) + ((size_t)g * 64 + lane) * 2; lbr = tl[0]; lbi = tl[1]; }
    float xr = 0.f, xi = 0.f;
#pragma unroll
    for (int sc = 0; sc < 4; ++sc) {
        s5_bu_tile(uf[sc], lane, frag, XSb);
#pragma unroll 4
        for (int t = 0; t < 16; ++t) { const float bur = bf1(XSb[t * XSB_STRIDE + lane]), bui = bf1(XSb[t * XSB_STRIDE + 64 + lane]);
            const float nxr = lbr * xr - lbi * xi + bur, nxi = lbr * xi + lbi * xr + bui; xr = nxr; xi = nxi; }
        asm volatile("s_waitcnt lgkmcnt(0)" ::: "memory");
    }
    float* xe = (float*)(p.ws + O_XEND) + ((size_t)unit * 64 + lane) * 2; xe[0] = xr; xe[1] = xi;
}
__device__ __forceinline__ void s5_combine(const Params& p, int idx) {
    const int pp = idx & 63, g = (idx >> 6) & 31, b = idx >> 11;
    const float dt = expf(p.in[19][g]); const float lr = p.in[12][g * 64 + pp], li = p.in[13][g * 64 + pp];
    const float mag = expf(lr * dt); float sn, cs; sincosf(li * dt, &sn, &cs); float ar = mag * cs, ai = mag * sn;
#pragma unroll
    for (int k = 0; k < 6; ++k) { const float nr = ar * ar - ai * ai, ni = 2.0f * ar * ai; ar = nr; ai = ni; }
    float xr = 0.f, xi = 0.f;
    const float* xe = (const float*)(p.ws + O_XEND); float* xp = (float*)(p.ws + O_XPREV);
    for (int c = 0; c < 32; ++c) { const size_t o = (((size_t)(b * 32 + g) * 32 + c) * 64 + pp) * 2;
        xp[o] = xr; xp[o + 1] = xi; const float er = xe[o], ei = xe[o + 1];
        const float nr = ar * xr - ai * xi + er, ni = ar * xi + ai * xr + ei; xr = nr; xi = ni; }
}
__device__ __forceinline__ void s5_pass2(const Params& p, LAS unsigned char* lds, int unit) {
    const int tid2 = fresh_tid(); const int lane = tid2 & 63, wave = tid2 >> 6, fr = lane & 15, fq = lane >> 4;
    const int c = unit & 31, g = (unit >> 5) & 31, b = unit >> 10;
    LAS float* XS = (LAS float*)(lds + wave * 8448);
    float lbr, lbi, bbr[16], bbi[16]; s5_consts(p, g, lane, lbr, lbi, bbr, bbi);
    const int rowb = b * SEQ + c * 64;
    const bf16_t* ub = (const bf16_t*)(p.ws + O_U);
    const bf16_t* up = ub + (size_t)(rowb + lane) * 512 + g * 16;
    unsigned ur[8]; { const u32x4 a = *(const u32x4*)up, bq = *(const u32x4*)(up + 8); ur[0] = a.x; ur[1] = a.y; ur[2] = a.z; ur[3] = a.w; ur[4] = bq.x; ur[5] = bq.y; ur[6] = bq.z; ur[7] = bq.w; }
    float cc[32];
#pragma unroll
    for (int ks = 0; ks < 32; ++ks) { const int k = 4 * ks + fq; cc[ks] = ks < 16 ? p.in[16][(size_t)(g * 16 + fr) * 64 + k] : -p.in[17][(size_t)(g * 16 + fr) * 64 + (k - 64)]; }
    const f32x4 dd = *(const f32x4*)(p.in[18] + g * 16 + 4 * fq);
    float xr = 0.f, xi = 0.f;
    {
        float ar = lbr, ai = lbi;
#pragma unroll
        for (int k = 0; k < 6; ++k) { const float nr = ar * ar - ai * ai, ni = 2.0f * ar * ai; ar = nr; ai = ni; }
        const float* xe = (const float*)(p.ws + O_XEND) + ((size_t)(unit - c) * 64 + lane) * 2;
        for (int c2 = 0; c2 < c; ++c2) { const float er = xe[c2 * 128], ei = xe[c2 * 128 + 1]; const float nr = ar * xr - ai * xi + er, ni = ar * xi + ai * xr + ei; xr = nr; xi = ni; }
    }
    bf16_t* yg = (bf16_t*)(p.ws + O_YG);
#pragma unroll 1
    for (int sc = 0; sc < 4; ++sc) {
#pragma unroll 4
        for (int t16 = 0; t16 < 16; ++t16) { S5_STEP(sc * 16 + t16); XS[t16 * 130 + lane] = xr; XS[t16 * 130 + 64 + lane] = xi; }
        asm volatile("s_waitcnt lgkmcnt(0)" ::: "memory");
        f32x4 acc = (f32x4){0.f, 0.f, 0.f, 0.f};
#pragma unroll
        for (int ks = 0; ks < 32; ++ks) acc = __builtin_amdgcn_mfma_f32_16x16x4f32(cc[ks], XS[fr * 130 + 4 * ks + fq], acc, 0, 0, 0);
        const int row = rowb + sc * 16 + fr;
        const u32x2 uw = *(const u32x2*)(ub + (size_t)row * 512 + g * 16 + 4 * fq);
        f32x4 y; y.x = acc[0] + dd.x * bflo(uw.x); y.y = acc[1] + dd.y * bfhi(uw.x); y.z = acc[2] + dd.z * bflo(uw.y); y.w = acc[3] + dd.w * bfhi(uw.y);
        y.x = gelu_tanh(y.x); y.y = gelu_tanh(y.y); y.z = gelu_tanh(y.z); y.w = gelu_tanh(y.w);
        pg8::st_bf4(yg + (size_t)row * 512 + g * 16 + 4 * fq, y);
        asm volatile("s_waitcnt lgkmcnt(0)" ::: "memory");
    }
}

constexpr size_t O_BAR = 524288;
#define XB_TMO      128
#define XB_XCNT(j)  (256  + 64 * (j))
#define XB_XSUB(j)  (1280 + 64 * (j))
#define XB_XGEN(j)  (2304 + 64 * (j))
#define XB_TOP      3328
#define XB_TOPGEN   3392
#define XCD_BAR_WORDS 3456
#define XB_SPIN_CAP (1u << 22)
__device__ __forceinline__ unsigned xb_ld(unsigned* p)              { return __hip_atomic_load(p, __ATOMIC_RELAXED, __HIP_MEMORY_SCOPE_AGENT); }
__device__ __forceinline__ unsigned xb_add(unsigned* p, unsigned v) { return __hip_atomic_fetch_add(p, v, __ATOMIC_RELAXED, __HIP_MEMORY_SCOPE_AGENT); }
__device__ __forceinline__ unsigned xb_xcc_id() { return (unsigned)__builtin_amdgcn_s_getreg((3 << 11) | 20) & 0xFu; }
#define XB_SPIN(cond, bar) do { unsigned _sp = 0; while (cond) { __builtin_amdgcn_s_sleep(1); \
    if ((++_sp & 255u) == 0u) { if (xb_ld(&(bar)[XB_TMO])) break; if (_sp > XB_SPIN_CAP) { atomicAdd(&(bar)[XB_TMO], 1u); break; } } } } while (0)
struct XcdBarrier { unsigned* bar; unsigned x; volatile LAS unsigned* st; };
__device__ __forceinline__ XcdBarrier xcd_barrier_post(unsigned* bar, volatile LAS unsigned* st) {
    XcdBarrier b; b.bar = bar; b.x = xb_xcc_id(); b.st = st;
    if (threadIdx.x == 0) (void)xb_add(&bar[XB_XCNT(b.x)], 1u);
    return b;
}
__device__ __forceinline__ void xcd_barrier_complete(unsigned* bar, unsigned x, unsigned& nloc, unsigned& nx) {
    const unsigned G = gridDim.x * gridDim.y * gridDim.z;
    unsigned sum, cnt, mine, sp = 0u;
    for (;;) {
        sum = 0u; cnt = 0u; mine = 0u;
#pragma unroll
        for (unsigned j = 0; j < 16; ++j) { const unsigned c = xb_ld(&bar[XB_XCNT(j)]); sum += c; cnt += (c > 0u) ? 1u : 0u; mine = (j == x) ? c : mine; }
        if (sum == G) break;
        __builtin_amdgcn_s_sleep(1);
        if ((++sp & 255u) == 0u) { if (xb_ld(&bar[XB_TMO])) break; if (sp > XB_SPIN_CAP) { atomicAdd(&bar[XB_TMO], 1u); break; } }
    }
    nloc = mine > 0u ? mine : 1u; nx = cnt > 0u ? cnt : 1u;
}
__device__ __forceinline__ void xcd_barrier(const XcdBarrier& b) {
    asm volatile("s_waitcnt vmcnt(0)" ::: "memory");
    __syncthreads();
    if (threadIdx.x == 0) {
        unsigned* bar = b.bar;
        __builtin_amdgcn_s_waitcnt(0);
        unsigned nloc = b.st[0], nx = b.st[1];
        if (nloc == 0u) { xcd_barrier_complete(bar, b.x, nloc, nx); b.st[0] = nloc; b.st[1] = nx; }
        const unsigned old = xb_add(&bar[XB_XSUB(b.x)], 1u);
        const unsigned gen = old / nloc;
        if (old + 1u == (gen + 1u) * nloc) {
            __builtin_amdgcn_fence(__ATOMIC_RELEASE, "agent");
            asm volatile("s_waitcnt vmcnt(0)" ::: "memory");
            const unsigned og = xb_add(&bar[XB_TOP], 1u);
            const unsigned tg = og / nx;
            if (og + 1u == (tg + 1u) * nx) xb_add(&bar[XB_TOPGEN], 1u);
            else XB_SPIN(xb_ld(&bar[XB_TOPGEN]) == tg, bar);
            __builtin_amdgcn_fence(__ATOMIC_ACQUIRE, "agent");
            xb_add(&bar[XB_XGEN(b.x)], 1u);
            asm volatile("s_waitcnt vmcnt(0)" ::: "memory");
        } else {
            XB_SPIN(xb_ld(&bar[XB_XGEN(b.x)]) == gen, bar);
            __builtin_amdgcn_fence(__ATOMIC_ACQUIRE, "agent");
            asm volatile("s_waitcnt vmcnt(0)" ::: "memory");
        }
    }
    __syncthreads();
}

template <int ONLYT> __global__ void __launch_bounds__(512) fwd_kernel(Params p) {
    extern __shared__ __attribute__((aligned(16))) unsigned char lds_raw[];
    LAS unsigned char* lds = (LAS unsigned char*)lds_raw;
    cg::grid_group grid = cg::this_grid();
    const int G = gridDim.x, bx = blockIdx.x;
    unsigned char* ws = p.ws;
    float* SSQ = (float*)(ws + O_SSQ);
    float* X = p.out; bf16_t* XB = (bf16_t*)(ws + O_XB);

    volatile LAS unsigned* bst = (volatile LAS unsigned*)(lds + LDS_BYTES - 64);
    if (threadIdx.x < 2) bst[threadIdx.x] = 0u;
    __syncthreads();
    XcdBarrier xbar; xbar.bar = (unsigned*)(ws + O_BAR); xbar.x = 0; xbar.st = bst;
    if (ONLYT < 0) xbar = xcd_barrier_post((unsigned*)(ws + O_BAR), bst);
#ifndef PROBE_A
#define PROBE_A -1
#define PROBE_B -1
#endif
    unsigned long long* tsbuf = (unsigned long long*)(ws + O_BAR + 65536); int seam = 0;
#define STAMP() do { if (PROBE_A >= 0) { if (blockIdx.x == 0 && threadIdx.x == 0) tsbuf[seam] = __builtin_amdgcn_s_memrealtime(); ++seam; } } while (0)
#define GRID_SYNC() do { if (ONLYT < 0) xcd_barrier(xbar); STAMP(); } while (0)
    STAMP();
    if (PH(0)) phase_prologue(p, lds, G);
    if (ONLYT < 0) grid.sync();
    STAMP();

    if (PH(1)) {
        pg8::SchedPlain S{(const char*)XB, (const char*)(ws + O_WIN), 1024, 1024, 64, 11, G, bx, 0, 256};
        pg8::EpiWin E{SSQ, (bf16_t*)(ws + O_QKVRAW), (bf16_t*)(ws + O_GATE), (float*)(ws + O_BA), (bf16_t*)(ws + O_U)};
        pg8::gemm_phase(lds, 1024, 1024, 1024, S, E);
        pg8::SchedKV S2{(const char*)(ws + O_MEMN), (const char*)(ws + O_WKV), 0, G == 256 ? bx - 192 : bx};
        pg8::EpiKV E2{(bf16_t*)(ws + O_KM), (bf16_t*)(ws + O_VT)};
        pg8::gemm_phase(lds, 1024, 1024, 1024, S2, E2);
    }
    GRID_SYNC();

    if (PH(2)) for (int ch = bx; ch < 1024; ch += G) delta_prep(p, lds, ch);
    if (PH(3)) for (int un = bx * 8 + (fresh_tid() >> 6); un < 8192; un += G * 8) s5_pass1(p, lds, un);
    GRID_SYNC();
    if (PH(5)) for (int it = bx; it < 256; it += G) delta_scan(p, lds, (((it & 7) + 8 * (it >> 6)) << 3) + ((it >> 3) & 7), G);
    GRID_SYNC();

    if (PH(7)) {
        const int tid = fresh_tid(), lane = tid & 63, wave = tid >> 6;
        const float* od = (const float*)(ws + O_ODELTA); const bf16_t* gt = (const bf16_t*)(ws + O_GATE); bf16_t* mx = (bf16_t*)(ws + O_MIXED);
        const f32x4* og = (const f32x4*)(p.in[11] + (lane & 15) * 8);
        const f32x4 g0 = og[0], g1 = og[1];
        const bool lowh = (G == 256) && (bx < 128); const int rbeg = (G == 256) ? (lowh ? 0 : 5440) : 0, rend = (G == 256) ? (lowh ? 5440 : MT) : MT;
        const int rstep = (G == 256) ? 1024 : G * 8, rfirst = (G == 256) ? rbeg + (bx & 127) * 8 + wave : bx * 8 + wave;
        for (int r = rfirst; r < rend; r += rstep) {
            const f32x4* op = (const f32x4*)(od + (size_t)r * 512 + lane * 8); const f32x4 a = op[0], bq = op[1];
            float s = (a.x * a.x + a.y * a.y) + (a.z * a.z + a.w * a.w) + (bq.x * bq.x + bq.y * bq.y) + (bq.z * bq.z + bq.w * bq.w);
            s += __shfl_xor(s, 1); s += __shfl_xor(s, 2); s += __shfl_xor(s, 4); s += __shfl_xor(s, 8);
            const float rs = rsqrtf(s * (1.0f / 128.0f) + EPS);
            const u32x4 gw = *(const u32x4*)(gt + (size_t)r * 512 + lane * 8);
            u32x4 o;
            o.x = pk2(a.x * rs * g0.x * silu_f(bflo(gw.x)), a.y * rs * g0.y * silu_f(bfhi(gw.x)));
            o.y = pk2(a.z * rs * g0.z * silu_f(bflo(gw.y)), a.w * rs * g0.w * silu_f(bfhi(gw.y)));
            o.z = pk2(bq.x * rs * g1.x * silu_f(bflo(gw.z)), bq.y * rs * g1.y * silu_f(bfhi(gw.z)));
            o.w = pk2(bq.z * rs * g1.z * silu_f(bflo(gw.w)), bq.w * rs * g1.w * silu_f(bfhi(gw.w)));
            *(u32x4*)(mx + (size_t)r * 1024 + lane * 8) = o;
        }
    }
    if (PH(8)) {
        pg8::SchedPlain S{(const char*)(ws + O_YG), (const char*)(ws + O_WGLU), 512, 512, 64, 2, G, bx, 0, 256};
        pg8::EpiGlu E{(const bf16_t*)(ws + O_YG), p.in[21], (bf16_t*)(ws + O_MIXED)};
        pg8::gemm_phase(lds, 512, 512, 512, S, E);
    }
    GRID_SYNC();

    if (PH(9)) {
        pg8::SchedPlain S{(const char*)(ws + O_MIXED), (const char*)(ws + O_WOUT), 1024, 1024, 64, 4, G, bx, 0, 256};
        pg8::EpiRes E{p.in[0], X, XB, SSQ + 1 * MT, nullptr};
        pg8::gemm_phase(lds, 1024, 1024, 1024, S, E);
    }
    GRID_SYNC();

#pragma unroll 1
    for (int layer = p.l_lo; layer < p.l_hi; ++layer) {
        if (layer == 1) {
          if (PH(10)) {
            const int tid = fresh_tid();
            const float* ssq = SSQ + 3 * MT; const float* gm = p.in[2] + 1024; bf16_t* dp = (bf16_t*)(ws + O_DPOOL);
            for (int ui = 0; ; ++ui) { int tpm, tpn; if (!pg8::tile_order(ui, G, bx, 64, 4, tpm, tpn)) break;
                const int col = 256 * tpn + 4 * (tid & 63), w = 2 << tpn;
                const int r0 = 256 * tpm + 32 * (tid >> 6); const f32x4 gg = *(const f32x4*)(gm + col);
                f32x4 s = (f32x4){0.f, 0.f, 0.f, 0.f};
                {
                    f32x4 hx[15]; float hs[15];
#pragma unroll
                    for (int k = 1; k <= 15; ++k) { const bool ok = (k < w) && ((r0 & 2047) - k >= 0); const int rc = ok ? r0 - k : r0; hx[k - 1] = *(const f32x4*)(X + (size_t)rc * 1024 + col); hs[k - 1] = ld_ssq(ssq + rc); }
#pragma unroll
                    for (int k = 1; k <= 15; ++k) { const bool ok = (k < w) && ((r0 & 2047) - k >= 0); if (ok) s = s + hx[k - 1] * (rsqrtf(hs[k - 1] * (1.0f / 1024.0f) + EPS)) * gg; }
                }
#pragma unroll 1
                for (int bq = 0; bq < 4; ++bq) {
                    f32x4 nx[8], lx[8]; float ns[8], ls[8];
#pragma unroll
                    for (int i = 0; i < 8; ++i) { const int r = r0 + 8 * bq + i; nx[i] = *(const f32x4*)(X + (size_t)r * 1024 + col); ns[i] = ld_ssq(ssq + r);
                        const bool lok = ((r & 2047) - w + 1 >= 0); const int rl = lok ? r - w + 1 : r; lx[i] = *(const f32x4*)(X + (size_t)rl * 1024 + col); ls[i] = ld_ssq(ssq + rl); }
#pragma unroll
                    for (int i = 0; i < 8; ++i) { const int r = r0 + 8 * bq + i, ts = r & 2047;
                        const f32x4 xn = nx[i] * (rsqrtf(ns[i] * (1.0f / 1024.0f) + EPS)) * gg;
                        s = s + xn; const float inv = 1.0f / (float)(ts + 1 < w ? ts + 1 : w);
                        pg8::st_bf4(dp + (size_t)r * 1024 + col, s * inv - xn);
                        if (ts - w + 1 >= 0) s = s - lx[i] * (rsqrtf(ls[i] * (1.0f / 1024.0f) + EPS)) * gg; }
                }
            }
            asm volatile("s_waitcnt vmcnt(0)" ::: "memory"); __syncthreads();
          }
            if (PH(19)) {
                pg8::SchedPlain S{(const char*)(ws + O_DPOOL), (const char*)(ws + O_POOL), 1024, 256, 64, 4, G, bx, 256, 256};
                pg8::EpiRes E{X, X, XB, SSQ + 4 * MT, p.in[24]};
                pg8::gemm_phase(lds, 1024, 256, 256, S, E);
            }
            GRID_SYNC();
        }
        const int sx = layer == 0 ? 1 : 4;
        if (PH(11)) {
            pg8::SchedPlain S{(const char*)XB, (const char*)(ws + O_WQ + (size_t)layer * 2097152), 1024, 1024, 64, 4, G, bx, 0, 256};
            pg8::EpiScaleBf E{SSQ + sx * MT, (bf16_t*)(ws + O_Q), 1024, 0.0625f};
            pg8::gemm_phase(lds, 1024, 1024, 1024, S, E);
        }
        GRID_SYNC();
        if (PH(12)) {
            pg8::SchedAttn S{(const char*)(ws + O_Q), (const char*)(ws + O_KM + (size_t)layer * 4194304), 0, G, bx};
            pg8::EpiSoftmax E{(bf16_t*)(ws + O_P)};
            pg8::gemm_phase(lds, 1024, 1024, 256, S, E);
        }
        GRID_SYNC();
        if (PH(13)) {
            pg8::SchedAttn S{(const char*)(ws + O_P), (const char*)(ws + O_VT + (size_t)layer * 4194304), 1, G, bx};
            pg8::EpiScaleBf E{nullptr, (bf16_t*)(ws + O_O), 1024, 1.0f};
            pg8::gemm_phase(lds, 1024, 256, 256, S, E);
        }
        GRID_SYNC();
        if (PH(14)) {
            pg8::SchedPlain S{(const char*)(ws + O_O), (const char*)(ws + O_WO + (size_t)layer * 2097152), 1024, 1024, 64, 4, G, bx, 0, 256};
            pg8::EpiRes E{X, X, XB, SSQ + (sx + 1) * MT, nullptr};
            pg8::gemm_phase(lds, 1024, 1024, 1024, S, E);
        }
        GRID_SYNC();
        if (PH(15)) {
            pg8::SchedPlain S{(const char*)XB, (const char*)(ws + O_WUP + (size_t)layer * 11534336), 1024, 1024, 64, 22, G, bx, 0, 256};
            pg8::EpiUp E{SSQ + (sx + 1) * MT, p.in[29] + (size_t)layer * 3 * FF2, (bf16_t*)(ws + O_ACT), (float*)(ws + O_HALO)};
            pg8::gemm_phase(lds, 1024, 1024, 1024, S, E);
            if (layer == 0) {
                pg8::SchedKV S2{(const char*)(ws + O_MEMN), (const char*)(ws + O_WKV), 64, G == 256 ? bx - 128 : bx};
                pg8::EpiKV E2{(bf16_t*)(ws + O_KM), (bf16_t*)(ws + O_VT)};
                pg8::gemm_phase(lds, 1024, 1024, 1024, S2, E2);
            }
        }
        GRID_SYNC();
        if (PH(17)) {
            {
                const int tid = fresh_tid();
                const float* hl = (const float*)(ws + O_HALO); const float* cw = p.in[29] + (size_t)layer * 3 * FF2; bf16_t* act = (bf16_t*)(ws + O_ACT);
                for (int ui = 0; ; ++ui) { int pm, tpn; if (!pg8::tile_order(ui, G, bx, 64, 4, pm, tpn)) break;
                    if ((pm & 7) == 0) continue;
                    for (int ch = tid; ch < FF; ch += 512) {
                        const int pg = (ch >> 7) * 256 + (ch & 127), pv = pg + 128;
                        const float* hp = hl + (size_t)(pm - 1) * 4 * FF2; const float* hc = hl + (size_t)pm * 4 * FF2;
                        const float gm2 = hp[2 * FF2 + pg], gm1 = hp[3 * FF2 + pg], g0 = hc[pg], g1 = hc[FF2 + pg];
                        const float vm2 = hp[2 * FF2 + pv], vm1 = hp[3 * FF2 + pv], v0 = hc[pv], v1 = hc[FF2 + pv];
                        const float a0 = cw[ch], a1 = cw[FF2 + ch], a2 = cw[2 * FF2 + ch], b0 = cw[FF + ch], b1 = cw[FF2 + FF + ch], b2 = cw[2 * FF2 + FF + ch];
                        const float o0 = silu_f(a2 * g0 + a1 * gm1 + a0 * gm2) * (b2 * v0 + b1 * vm1 + b0 * vm2);
                        const float o1 = silu_f(a2 * g1 + a1 * g0 + a0 * gm1) * (b2 * v1 + b1 * v0 + b0 * vm1);
                        act[(size_t)(pm * 256) * FF + ch] = (bf16_t)f2bf(o0); act[(size_t)(pm * 256 + 1) * FF + ch] = (bf16_t)f2bf(o1);
                    }
                }
                asm volatile("s_waitcnt vmcnt(0)" ::: "memory"); __syncthreads();
            }
            pg8::SchedPlain S{(const char*)(ws + O_ACT), (const char*)(ws + O_WDN + (size_t)layer * 5767168), FF, FF, 64, 4, G, bx, 0, 256};
            pg8::EpiRes E{X, X, nullptr, SSQ + (sx + 2) * MT, nullptr};
            pg8::gemm_phase(lds, FF, FF, FF, S, E);
        }
        GRID_SYNC();
    }
    if (PH(18)) {
        const int tid = fresh_tid(), lane = tid & 63, wave = tid >> 6;
        const float* ssq = SSQ + 6 * MT; const f32x4* gf = (const f32x4*)p.in[6] + lane;
        f32x4 gq[4];
#pragma unroll
        for (int j = 0; j < 4; ++j) gq[j] = gf[64 * j];
        const int st8 = G * 8;
        for (int r = bx * 8 + wave; r < MT; r += 2 * st8) {
            const int r2 = r + st8 < MT ? r + st8 : r; const bool two = r + st8 < MT;
            f32x4* xp = (f32x4*)(X + (size_t)r * 1024) + lane; f32x4* xq = (f32x4*)(X + (size_t)r2 * 1024) + lane;
            f32x4 a[4], bq[4]; const float sa = ld_ssq(ssq + r), sb = ld_ssq(ssq + r2);
#pragma unroll
            for (int j = 0; j < 4; ++j) { a[j] = xp[64 * j]; bq[j] = xq[64 * j]; }
            const float ra = rsqrtf(sa * (1.0f / 1024.0f) + EPS), rb = rsqrtf(sb * (1.0f / 1024.0f) + EPS);
#pragma unroll
            for (int j = 0; j < 4; ++j) xp[64 * j] = a[j] * ra * gq[j];
            if (two) {
#pragma unroll
                for (int j = 0; j < 4; ++j) xq[64 * j] = bq[j] * rb * gq[j];
            }
            if (PROBE_A >= 0) {
                const float dA = (float)(tsbuf[PROBE_A] - tsbuf[0]) * 1e-4f, eB = (float)(tsbuf[PROBE_B] - tsbuf[0]) * 1e-2f;
#pragma unroll
                for (int j = 0; j < 4; ++j) xp[64 * j] = xp[64 * j] + dA;
                if (r == 0 && lane == 0) { f32x4 v = xp[0]; v.x += eB; xp[0] = v; }
            }
        }
    }
}

#ifndef MULTI_LAUNCH
#define MULTI_LAUNCH 0
#endif
template <int K> static void launch_phase(const Params& p, int lo, int hi, int grid, hipStream_t stream) {
    static bool attr = false;
    if (!attr) { (void)hipFuncSetAttribute((const void*)fwd_kernel<K>, hipFuncAttributeMaxDynamicSharedMemorySize, LDS_BYTES); attr = true; }
    Params q = p; q.l_lo = lo; q.l_hi = hi;
    hipLaunchKernelGGL(fwd_kernel<K>, dim3(grid), dim3(512), LDS_BYTES, stream, q);
}
extern "C" void kernel_launch(void* const* d_in, const int* in_sizes, int n_in, void* d_out, int out_size, void* d_ws, size_t ws_size, hipStream_t stream) {
    Params p{};
    for (int i = 0; i < 31; ++i) p.in[i] = (const float*)d_in[i];
    p.out = (float*)d_out; p.ws = (unsigned char*)d_ws; p.l_lo = 0; p.l_hi = 2;
#if MULTI_LAUNCH
    const int g = 256;
    launch_phase<0>(p, 0, 0, g, stream); launch_phase<1>(p, 0, 0, g, stream); launch_phase<2>(p, 0, 0, g, stream); launch_phase<3>(p, 0, 0, g, stream);
    launch_phase<4>(p, 0, 0, g, stream); launch_phase<5>(p, 0, 0, g, stream); launch_phase<6>(p, 0, 0, g, stream); launch_phase<7>(p, 0, 0, g, stream);
    launch_phase<8>(p, 0, 0, g, stream); launch_phase<9>(p, 0, 0, g, stream);
    for (int l = 0; l < 2; ++l) {
        if (l == 1) { launch_phase<10>(p, 1, 2, g, stream); launch_phase<19>(p, 1, 2, g, stream); }
        launch_phase<11>(p, l, l + 1, g, stream); launch_phase<12>(p, l, l + 1, g, stream); launch_phase<13>(p, l, l + 1, g, stream); launch_phase<14>(p, l, l + 1, g, stream);
        launch_phase<15>(p, l, l + 1, g, stream); launch_phase<16>(p, l, l + 1, g, stream); launch_phase<17>(p, l, l + 1, g, stream);
    }
    launch_phase<18>(p, 0, 0, g, stream);
#else
    static int grid_blocks = 0;
    if (!grid_blocks) {
        int dev = 0, cus = 0, per_cu = 0;
        (void)hipGetDevice(&dev);
        (void)hipDeviceGetAttribute(&cus, hipDeviceAttributeMultiprocessorCount, dev);
        (void)hipFuncSetAttribute((const void*)fwd_kernel<-1>, hipFuncAttributeMaxDynamicSharedMemorySize, LDS_BYTES);
        (void)hipOccupancyMaxActiveBlocksPerMultiprocessor(&per_cu, (const void*)fwd_kernel<-1>, 512, LDS_BYTES);
        if (per_cu < 1) { fprintf(stderr, "occupancy query returned %d\n", per_cu); per_cu = 1; }
        grid_blocks = cus * per_cu;
        if (grid_blocks > 256) grid_blocks = 256;
    }
    (void)hipMemsetAsync((char*)d_ws + O_BAR, 0, 16384, stream);
    void* args[] = {&p};
    hipError_t e = hipLaunchCooperativeKernel((const void*)fwd_kernel<-1>, dim3(grid_blocks), dim3(512), args, LDS_BYTES, stream);
    if (e != hipSuccess) fprintf(stderr, "cooperative launch failed: %s (grid %d)\n", hipGetErrorString(e), grid_blocks);
#endif
}
```

```cpp
#include <hip/hip_runtime.h>
#include <hip/hip_cooperative_groups.h>
#include <cstdio>
#include <cstdint>
namespace cg = cooperative_groups;

#define LAS __attribute__((address_space(3)))
typedef unsigned short bf16_t;
typedef short bf16x8 __attribute__((ext_vector_type(8)));
typedef float f32x4 __attribute__((ext_vector_type(4)));
typedef unsigned u32x4 __attribute__((ext_vector_type(4)));
typedef unsigned u32x2 __attribute__((ext_vector_type(2)));

constexpr int MT = 16384, DM = 1024, SEQ = 2048, NBATCH = 8;
constexpr int NIN = 2568, FF = 2816, FF2 = 5632;
constexpr float EPS = 1e-6f;
constexpr size_t HM = 524288;
constexpr size_t O_SSQ = 0;
constexpr size_t O_GL = 480 * 1024;
constexpr size_t O_WIN = 2 * HM;
constexpr size_t O_WGLU = 13 * HM;
constexpr size_t O_WOUT = 14 * HM;
constexpr size_t O_WQ = 18 * HM;
constexpr size_t O_WKV = 26 * HM;
constexpr size_t O_WO = 42 * HM;
constexpr size_t O_WUP = 50 * HM;
constexpr size_t O_WDN = 94 * HM;
constexpr size_t O_POOL = 116 * HM;
constexpr size_t O_MEMN = 117 * HM;
constexpr size_t O_KM = 125 * HM;
constexpr size_t O_VT = 141 * HM;
constexpr size_t O_XEND = 157 * HM;
constexpr size_t O_XPREV = 165 * HM;
constexpr size_t O_BA = 173 * HM;
constexpr size_t O_HALO = 174 * HM;
constexpr size_t O_XB = 186 * HM;
constexpr size_t O_R = 250 * HM;
constexpr size_t O_QKVRAW = O_R;
constexpr size_t O_GATE = O_R + 96 * HM;
constexpr size_t O_U = O_R + 128 * HM;
constexpr size_t O_DP2 = O_R + 160 * HM;
constexpr size_t O_DP1 = O_XB;
constexpr size_t O_ODELTA = O_R;
constexpr size_t O_YG = O_R + 64 * HM;
constexpr size_t O_MIXED = O_R + 160 * HM;
constexpr size_t O_Q = O_R;
constexpr size_t O_P = O_R + 64 * HM;
constexpr size_t O_O = O_R;
constexpr size_t O_ACT = O_R;
constexpr size_t O_DPOOL = O_R;
constexpr int LDS_BYTES = 163840;
constexpr int LDS_SCR = 131072;

struct Params { const float* in[31]; float* out; unsigned char* ws; int l_lo, l_hi; };
#define PH(k) (ONLYT < 0 || ONLYT == (k))

__device__ __forceinline__ unsigned f2bf(float f) { unsigned u = __float_as_uint(f); return (u + 0x7fffu + ((u >> 16) & 1u)) >> 16; }
typedef float f32x2_t __attribute__((ext_vector_type(2))); typedef __bf16 bf16x2_t __attribute__((ext_vector_type(2)));
__device__ __forceinline__ unsigned pk2(float lo, float hi) { const f32x2_t v = {lo, hi}; const bf16x2_t b = __builtin_convertvector(v, bf16x2_t); return __builtin_bit_cast(unsigned, b); }
__device__ __forceinline__ float bflo(unsigned w) { return __uint_as_float(w << 16); }
__device__ __forceinline__ float bfhi(unsigned w) { return __uint_as_float(w & 0xffff0000u); }
__device__ __forceinline__ float bf1(bf16_t h) { return __uint_as_float(((unsigned)h) << 16); }
__device__ __forceinline__ float wave_sum(float v) {
#pragma unroll
    for (int o = 1; o < 64; o <<= 1) v += __shfl_xor(v, o);
    return v;
}
__device__ __forceinline__ float ld_ssq(const float* p) { return __hip_atomic_load(p, __ATOMIC_RELAXED, __HIP_MEMORY_SCOPE_AGENT); }
__device__ __forceinline__ int fresh_tid() { int t = threadIdx.x; asm volatile("" : "+v"(t)); return t; }
__device__ __forceinline__ float silu_f(float x) { return x * __builtin_amdgcn_rcpf(1.0f + __expf(-x)); }
__device__ __forceinline__ float sigmoid_f(float x) { return __builtin_amdgcn_rcpf(1.0f + __expf(-x)); }
__device__ __forceinline__ float gelu_tanh(float v) {
    const float z = 0.7978845608f * (v + 0.044715f * v * v * v);
    const float e = __expf(2.0f * z);
    const float th = 1.0f - 2.0f * __builtin_amdgcn_rcpf(e + 1.0f);
    return 0.5f * v * (1.0f + th);
}
template <int CTRL> __device__ __forceinline__ float dppf(float x) { return __int_as_float(__builtin_amdgcn_update_dpp(0, __float_as_int(x), CTRL, 0xf, 0xf, false)); }
template <int CTRL> __device__ __forceinline__ f32x4 dpp4(f32x4 x) { f32x4 r; r.x = dppf<CTRL>(x.x); r.y = dppf<CTRL>(x.y); r.z = dppf<CTRL>(x.z); r.w = dppf<CTRL>(x.w); return r; }
#define WG_BARRIER() do { asm volatile("s_waitcnt vmcnt(0) lgkmcnt(0)" ::: "memory"); __builtin_amdgcn_s_barrier(); asm volatile("" ::: "memory"); } while (0)
#define LDS_BARRIER() do { asm volatile("s_waitcnt lgkmcnt(0)" ::: "memory"); __builtin_amdgcn_s_barrier(); asm volatile("" ::: "memory"); } while (0)

namespace pg8 {
constexpr int BM = 256, BK = 64, HALF = 128, HTB = HALF * BK * 2;
__device__ __forceinline__ int lds_byte(int r, int c) { const int st = (r >> 4) * 2 + (c >> 5), rr = r & 15, cc = c & 31, ob = rr * 64 + cc * 2; return st * 1024 + (ob ^ (((ob >> 9) & 1) << 5)); }
__device__ __forceinline__ void stage_rc(int b, int& R, int& C) { const int st = b / 1024, sb = b % 1024, swz = sb ^ (((sb >> 9) & 1) << 5); R = (st >> 1) * 16 + swz / 64; C = (st & 1) * 32 + (swz % 64) / 2; }

struct Unit { const char* A; const char* B; int row0, col0, aux; };

__device__ __forceinline__ bool tile_order(int i, int G, int c, int nM, int nN, int& pm, int& pn) {
    const int nwg = nM * nN; const long L = (long)i * G + c; if (L >= nwg) return false;
    int wgid = (int)L; { const int q = nwg / 8, r = nwg % 8, xcd = wgid % 8, off = wgid / 8; wgid = (xcd < r ? xcd * (q + 1) : r * (q + 1) + (xcd - r) * q) + off; }
    const int nig = 8 * nN, gid = wgid / nig, fm = gid * 8, gsz = (nM - fm) < 8 ? (nM - fm) : 8;
    pm = fm + ((wgid % nig) % gsz); pn = (wgid % nig) / gsz; return true;
}

template <class Epi, class Sched>
__device__ __forceinline__ void gemm_phase(LAS unsigned char* lds, const int lda, const int ldb, const int K, const Sched& S, const Epi& E) {
    int tid_ = threadIdx.x; asm volatile("" : "+v"(tid_));
    const int tid = tid_, wid = __builtin_amdgcn_readfirstlane(tid >> 6), lane = tid & 63, wr = wid >> 2, wc = wid & 3, fr = lane & 15, fq = lane >> 4;
    const int nt = K / BK;
    unsigned voffA[2], voffB[2];
#pragma unroll
    for (int i = 0; i < 2; ++i) { int R, C; stage_rc(tid * 16 + i * 8192, R, C); voffA[i] = (unsigned)(R * lda + C) * 2u; voffB[i] = (unsigned)(R * ldb + C) * 2u; }
    const size_t kstep = (size_t)(BK * 2);
    const size_t hstepA = (size_t)HALF * lda * 2, hstepB = (size_t)HALF * ldb * 2;
    const unsigned ldsw = (unsigned)wid * 1024u;
    const int aoff = lds_byte(wr * 64 + fr, fq * 8), boff = lds_byte(wc * 32 + fr, fq * 8);
#define PG8_SA(b, h) (((b) * 2 + (h)) * HTB)
#define PG8_SB(b, h) ((4 + (b) * 2 + (h)) * HTB)
#define PG8_STAGE(bufoff, gbase, voff) do { _Pragma("unroll") for (int _i = 0; _i < 2; ++_i) \
        __builtin_amdgcn_global_load_lds((const unsigned*)((const char*)(gbase) + (voff)[_i]), (LAS unsigned*)(lds + (bufoff) + ldsw + _i * 8192), 16, 0, 0); } while (0)
#define PG8_LDA(dst, b, h) do { _Pragma("unroll") for (int m = 0; m < 4; ++m) _Pragma("unroll") for (int k = 0; k < 2; ++k) dst[m][k] = *(const LAS bf16x8*)(lds + PG8_SA(b, h) + aoff + m * 2048 + k * 1024); } while (0)
#define PG8_LDB(dst, b, h) do { _Pragma("unroll") for (int n = 0; n < 2; ++n) _Pragma("unroll") for (int k = 0; k < 2; ++k) dst[n][k] = *(const LAS bf16x8*)(lds + PG8_SB(b, h) + boff + n * 2048 + k * 1024); } while (0)
#define PG8_MMA(ai, bj, At, Bt) do { __builtin_amdgcn_s_setprio(1); _Pragma("unroll") for (int m = 0; m < 4; ++m) _Pragma("unroll") for (int n = 0; n < 2; ++n) _Pragma("unroll") for (int k = 0; k < 2; ++k) \
        acc[ai][bj][m][n] = __builtin_amdgcn_mfma_f32_16x16x32_bf16(Bt[n][k], At[m][k], acc[ai][bj][m][n], 0, 0, 0); __builtin_amdgcn_s_setprio(0); } while (0)
#define PG8_WAIT_V(n) asm volatile("s_waitcnt vmcnt(" #n ")" ::: "memory")
#define PG8_WAIT_L(n) asm volatile("s_waitcnt lgkmcnt(" #n ")" ::: "memory")
#define PG8_BAR __builtin_amdgcn_s_barrier()
#define PG8_SCHED __builtin_amdgcn_sched_barrier(0)
    Unit cur, nxt; int ui = 0;
    if (!S.next(0, cur)) return;
    f32x4 acc[2][2][4][2];
#pragma unroll
    for (int a = 0; a < 2; ++a)
#pragma unroll
        for (int b = 0; b < 2; ++b)
#pragma unroll
            for (int m = 0; m < 4; ++m)
#pragma unroll
                for (int n = 0; n < 2; ++n) acc[a][b][m][n] = (f32x4){0.f, 0.f, 0.f, 0.f};
    bf16x8 At[4][2], B0[2][2], B1[2][2];
    const char* cA = cur.A; const char* cB = cur.B;
    PG8_STAGE(PG8_SB(0, 0), cB, voffB); PG8_STAGE(PG8_SB(0, 1), cB + hstepB, voffB); PG8_STAGE(PG8_SA(0, 0), cA, voffA); PG8_STAGE(PG8_SA(0, 1), cA + hstepA, voffA);
    if (wr == 1) PG8_BAR;
    PG8_WAIT_V(2); PG8_BAR;
    PG8_STAGE(PG8_SB(1, 0), cB + kstep, voffB); PG8_STAGE(PG8_SA(1, 0), cA + kstep, voffA); PG8_STAGE(PG8_SB(1, 1), cB + hstepB + kstep, voffB);
    PG8_WAIT_V(6); PG8_BAR;
    for (;;) {
        const bool has_next = S.next(ui + 1, nxt);
        const char* nA = has_next ? nxt.A : cA; const char* nB = has_next ? nxt.B : cB;
#pragma unroll 1
        for (int t = 0; t < nt; t += 2) {
            const bool last = (t == nt - 2);
            const char* a1 = cA + (size_t)(t + 1) * kstep;
            const char* a2 = last ? nA : cA + (size_t)(t + 2) * kstep; const char* b2 = last ? nB : cB + (size_t)(t + 2) * kstep;
            const char* a3 = a2 + kstep; const char* b3 = b2 + kstep;
            PG8_LDB(B0, 0, 0); PG8_LDB(B1, 0, 1); PG8_SCHED; PG8_LDA(At, 0, 0); PG8_STAGE(PG8_SA(1, 1), a1 + hstepA, voffA);
            PG8_WAIT_V(8); PG8_WAIT_L(0); PG8_BAR; PG8_MMA(0, 0, At, B0); PG8_MMA(0, 1, At, B1); PG8_BAR; PG8_SCHED;
            PG8_LDA(At, 0, 1); PG8_STAGE(PG8_SB(0, 0), b2, voffB); PG8_STAGE(PG8_SB(0, 1), b2 + hstepB, voffB); PG8_STAGE(PG8_SA(0, 0), a2, voffA);
            PG8_WAIT_V(8); PG8_WAIT_L(0); PG8_BAR; PG8_MMA(1, 0, At, B0); PG8_MMA(1, 1, At, B1); PG8_BAR; PG8_SCHED;
            PG8_LDB(B0, 1, 0); PG8_LDB(B1, 1, 1); PG8_SCHED; PG8_LDA(At, 1, 0); PG8_STAGE(PG8_SA(0, 1), a2 + hstepA, voffA);
            PG8_WAIT_V(8); PG8_WAIT_L(0); PG8_BAR; PG8_MMA(0, 0, At, B0); PG8_MMA(0, 1, At, B1); PG8_BAR; PG8_SCHED;
            PG8_LDA(At, 1, 1); PG8_STAGE(PG8_SB(1, 0), b3, voffB); PG8_STAGE(PG8_SB(1, 1), b3 + hstepB, voffB); PG8_STAGE(PG8_SA(1, 0), a3, voffA);
            PG8_WAIT_V(8); PG8_WAIT_L(0); PG8_BAR; PG8_MMA(1, 0, At, B0); PG8_MMA(1, 1, At, B1); PG8_BAR; PG8_SCHED;
        }
        if (wr == 0) PG8_BAR;
        { int efr = fr, efq = fq; asm volatile("" : "+v"(efr), "+v"(efq)); E(acc, cur, wr, wc, efr, efq, lds); }
        if (!has_next) break;
#pragma unroll
        for (int a = 0; a < 2; ++a)
#pragma unroll
            for (int b = 0; b < 2; ++b)
#pragma unroll
                for (int m = 0; m < 4; ++m)
#pragma unroll
                    for (int n = 0; n < 2; ++n) acc[a][b][m][n] = (f32x4){0.f, 0.f, 0.f, 0.f};
        cur = nxt; cA = nA; cB = nB; ++ui;
        if (wr == 1) PG8_BAR;
    }
    PG8_WAIT_V(0);
    PG8_BAR;
#undef PG8_SA
#undef PG8_SB
#undef PG8_STAGE
#undef PG8_LDA
#undef PG8_LDB
#undef PG8_MMA
#undef PG8_WAIT_V
#undef PG8_WAIT_L
#undef PG8_BAR
#undef PG8_SCHED
}

struct SchedPlain {
    const char* A; const char* B; int lda, ldb, nM, nN, G, c, acol, brow;
    __device__ __forceinline__ bool next(int i, Unit& u) const {
        int pm, pn; if (!tile_order(i, G, c, nM, nN, pm, pn)) return false;
        u.A = A + ((size_t)pm * 256 * lda + (size_t)pn * acol) * 2; u.B = B + (size_t)pn * brow * ldb * 2; u.row0 = pm * 256; u.col0 = pn * 256; u.aux = 0; return true;
    }
};
struct SchedAttn {
    const char* A; const char* B; int kind, G, c;
    __device__ __forceinline__ bool next(int i, Unit& u) const {
        const int L = i * G + c; if (L >= 256) return false;
        const int b = L >> 5, h = (L >> 3) & 3, qt = L & 7;
        u.row0 = b * 2048 + qt * 256; u.col0 = h * 256; u.aux = 0;
        u.A = A + ((size_t)u.row0 * 1024 + h * 256) * 2;
        u.B = kind == 0 ? B + ((size_t)(b * 256) * 1024 + h * 256) * 2 : B + ((size_t)(b * 1024 + h * 256) * 256) * 2;
        return true;
    }
};
struct SchedKV {
    const char* memn; const char* wkv; int base, c;
    __device__ __forceinline__ bool next(int i, Unit& u) const {
        if (i != 0 || c < 0 || c >= 64) return false;
        const int L = base + c;
        const int l = L >> 6, kind = (L >> 5) & 1, idx = L & 31; u.aux = l * 2 + kind;
        const char* w = wkv + (size_t)l * 2048 * 1024 * 2;
        if (kind == 0) { const int pm = idx >> 2, pn = idx & 3; u.A = memn + (size_t)pm * 256 * 1024 * 2; u.B = w + (size_t)pn * 256 * 1024 * 2; u.row0 = pm * 256; u.col0 = pn * 256; }
        else { const int b = idx >> 2, pm = idx & 3; u.A = w + (size_t)(1024 + pm * 256) * 1024 * 2; u.B = memn + (size_t)b * 256 * 1024 * 2; u.row0 = b * 1024 + pm * 256; u.col0 = 0; }
        return true;
    }
};

#define EPI_ARGS f32x4 (&acc)[2][2][4][2], const Unit& u, int wr, int wc, int fr, int fq, LAS unsigned char* lds
#define FOR_AI_M _Pragma("unroll") for (int ai = 0; ai < 2; ++ai) _Pragma("unroll") for (int m = 0; m < 4; ++m)
#define FOR_BJ_N _Pragma("unroll") for (int bj = 0; bj < 2; ++bj) _Pragma("unroll") for (int n = 0; n < 2; ++n)
__device__ __forceinline__ void st_bf4(bf16_t* p, f32x4 v) { u32x2 w; w.x = pk2(v.x, v.y); w.y = pk2(v.z, v.w); *(u32x2*)p = w; }

struct EpiWin {
    const float* ssq; bf16_t* qkv; bf16_t* gate; float* ba; bf16_t* uo;
    __device__ __forceinline__ void operator()(EPI_ARGS) const {
        FOR_AI_M { const int row = u.row0 + 128 * ai + 64 * wr + 16 * m + fr; const float rs = rsqrtf(ld_ssq(ssq + row) * (1.0f / 1024.0f) + EPS);
            FOR_BJ_N { const int c = u.col0 + 128 * bj + 32 * wc + 16 * n + 4 * fq; const f32x4 v = acc[ai][bj][m][n] * rs;
                if (c < 1536) st_bf4(qkv + (size_t)row * 1536 + c, v);
                else if (c < 2048) st_bf4(gate + (size_t)row * 512 + (c - 1536), v);
                else if (c < 2056) *(f32x4*)(ba + (size_t)row * 8 + (c - 2048)) = v;
                else if (c < NIN) st_bf4(uo + (size_t)row * 512 + (c - 2056), v); } }
    }
};
struct EpiRes {
    const float* Xin; float* X; bf16_t* XB; float* ssqn; const float* colscale;
    __device__ __forceinline__ void operator()(EPI_ARGS) const {
        FOR_AI_M { const int row = u.row0 + 128 * ai + 64 * wr + 16 * m + fr; float s = 0.f;
            FOR_BJ_N { const int c = u.col0 + 128 * bj + 32 * wc + 16 * n + 4 * fq; f32x4 a = acc[ai][bj][m][n];
                if (colscale) a = a * *(const f32x4*)(colscale + c);
                const f32x4 x = *(const f32x4*)(Xin + (size_t)row * 1024 + c) + a; *(f32x4*)(X + (size_t)row * 1024 + c) = x; if (XB) st_bf4(XB + (size_t)row * 1024 + c, x);
                s += (x.x * x.x + x.y * x.y) + (x.z * x.z + x.w * x.w); }
            s += __shfl_xor(s, 16); s += __shfl_xor(s, 32);
            if (fq == 0) atomicAdd(ssqn + row, s);
            asm volatile("" ::: "memory"); }
    }
};
struct EpiScaleBf {
    const float* ssq; bf16_t* out; int ldc; float scale;
    __device__ __forceinline__ void operator()(EPI_ARGS) const {
        FOR_AI_M { const int row = u.row0 + 128 * ai + 64 * wr + 16 * m + fr; const float rs = (ssq ? rsqrtf(ld_ssq(ssq + row) * (1.0f / 1024.0f) + EPS) : 1.0f) * scale;
            FOR_BJ_N { const int c = u.col0 + 128 * bj + 32 * wc + 16 * n + 4 * fq; st_bf4(out + (size_t)row * ldc + c, acc[ai][bj][m][n] * rs); } }
    }
};
struct EpiKV {
    bf16_t* km; bf16_t* vt;
    __device__ __forceinline__ void operator()(EPI_ARGS) const {
        const int l = u.aux >> 1, kind = u.aux & 1; bf16_t* o = kind == 0 ? km + (size_t)l * 2048 * 1024 : vt + (size_t)l * 8192 * 256; const int ldc = kind == 0 ? 1024 : 256;
        FOR_AI_M { const int row = u.row0 + 128 * ai + 64 * wr + 16 * m + fr;
            FOR_BJ_N { const int c = u.col0 + 128 * bj + 32 * wc + 16 * n + 4 * fq; st_bf4(o + (size_t)row * ldc + c, acc[ai][bj][m][n]); } }
    }
};
struct EpiGlu {
    const bf16_t* yg; const float* bias; bf16_t* mixed;
    __device__ __forceinline__ void operator()(EPI_ARGS) const {
        FOR_AI_M { const int row = u.row0 + 128 * ai + 64 * wr + 16 * m + fr;
            FOR_BJ_N { const int c = u.col0 + 128 * bj + 32 * wc + 16 * n + 4 * fq; const f32x4 z = acc[ai][bj][m][n] + *(const f32x4*)(bias + c);
                const u32x2 yw = *(const u32x2*)(yg + (size_t)row * 512 + c); f32x4 o;
                o.x = bflo(yw.x) * sigmoid_f(z.x); o.y = bfhi(yw.x) * sigmoid_f(z.y); o.z = bflo(yw.y) * sigmoid_f(z.z); o.w = bfhi(yw.y) * sigmoid_f(z.w);
                st_bf4(mixed + (size_t)row * 1024 + 512 + c, o); } }
    }
};
struct EpiSoftmax {
    bf16_t* P;
    __device__ __forceinline__ void operator()(EPI_ARGS) const {
        LAS float* smax = (LAS float*)(lds + LDS_SCR); LAS float* ssum = smax + 1024;
        FOR_AI_M { const int rl = 128 * ai + 64 * wr + 16 * m + fr; float mx = -3.0e38f;
            FOR_BJ_N { const f32x4 v = acc[ai][bj][m][n]; mx = fmaxf(mx, fmaxf(fmaxf(v.x, v.y), fmaxf(v.z, v.w))); }
            mx = fmaxf(mx, __shfl_xor(mx, 16)); mx = fmaxf(mx, __shfl_xor(mx, 32));
            if (fq == 0) smax[rl * 4 + wc] = mx; }
        LDS_BARRIER();
        FOR_AI_M { const int rl = 128 * ai + 64 * wr + 16 * m + fr; const f32x4 mm = *(const LAS f32x4*)(smax + rl * 4);
            const float mx = fmaxf(fmaxf(mm.x, mm.y), fmaxf(mm.z, mm.w)); float s = 0.f;
            FOR_BJ_N { f32x4 v = acc[ai][bj][m][n]; v.x = __expf(v.x - mx); v.y = __expf(v.y - mx); v.z = __expf(v.z - mx); v.w = __expf(v.w - mx); acc[ai][bj][m][n] = v; s += (v.x + v.y) + (v.z + v.w); }
            s += __shfl_xor(s, 16); s += __shfl_xor(s, 32);
            if (fq == 0) ssum[rl * 4 + wc] = s; }
        LDS_BARRIER();
        FOR_AI_M { const int rl = 128 * ai + 64 * wr + 16 * m + fr; const int row = u.row0 + rl; const f32x4 ss = *(const LAS f32x4*)(ssum + rl * 4);
            const float inv = 1.0f / ((ss.x + ss.y) + (ss.z + ss.w));
            FOR_BJ_N { const int c = u.col0 + 128 * bj + 32 * wc + 16 * n + 4 * fq; st_bf4(P + (size_t)row * 1024 + c, acc[ai][bj][m][n] * inv); } }
    }
};
struct EpiUp {
    const float* ssq; const float* cw; bf16_t* act; float* halo;
    __device__ __forceinline__ void operator()(EPI_ARGS) const {
        LAS float* hl = (LAS float*)(lds + LDS_SCR);
        const int pm = u.row0 >> 8, pn = u.col0 >> 8;
        FOR_AI_M { const int row = u.row0 + 128 * ai + 64 * wr + 16 * m + fr; const float rs = rsqrtf(ld_ssq(ssq + row) * (1.0f / 1024.0f) + EPS);
            FOR_BJ_N acc[ai][bj][m][n] = acc[ai][bj][m][n] * rs; }
#pragma unroll
        for (int ai = 0; ai < 2; ++ai) { const int strip = 2 * ai + wr;
            if (fr >= 14) { const int rr = fr - 14;
                FOR_BJ_N { const int lc = 128 * bj + 32 * wc + 16 * n + 4 * fq; *(LAS f32x4*)(hl + (strip * 2 + rr) * 256 + lc) = acc[ai][bj][3][n];
                    if (strip == 3) *(f32x4*)(halo + (size_t)(pm * 4 + 2 + rr) * FF2 + u.col0 + lc) = acc[ai][bj][3][n]; } }
            if (strip == 0 && fr < 2) { FOR_BJ_N { const int lc = 128 * bj + 32 * wc + 16 * n + 4 * fq; *(f32x4*)(halo + (size_t)(pm * 4 + fr) * FF2 + u.col0 + lc) = acc[ai][bj][0][n]; } } }
        LDS_BARRIER();
#pragma unroll
        for (int ai = 0; ai < 2; ++ai) { const int strip = 2 * ai + wr;
#pragma unroll
            for (int n = 0; n < 2; ++n) {
                const int lcg = 32 * wc + 16 * n + 4 * fq; const int ch = pn * 128 + lcg;
                const f32x4 wg0 = *(const f32x4*)(cw + ch), wg1 = *(const f32x4*)(cw + FF2 + ch), wg2 = *(const f32x4*)(cw + 2 * FF2 + ch);
                const f32x4 wv0 = *(const f32x4*)(cw + FF + ch), wv1 = *(const f32x4*)(cw + FF2 + FF + ch), wv2 = *(const f32x4*)(cw + 2 * FF2 + FF + ch);
                f32x4 hg1 = (f32x4){0.f, 0.f, 0.f, 0.f}, hg2 = hg1, hv1 = hg1, hv2 = hg1;
                if (strip > 0) { const LAS float* hp = hl + (strip - 1) * 512 + lcg; hg2 = *(const LAS f32x4*)hp; hg1 = *(const LAS f32x4*)(hp + 256); hv2 = *(const LAS f32x4*)(hp + 128); hv1 = *(const LAS f32x4*)(hp + 384); }
                f32x4 pg1 = hg1, pv1 = hv1, pg2 = (fr == 1) ? hg1 : hg2, pv2 = (fr == 1) ? hv1 : hv2;
#pragma unroll
                for (int m = 0; m < 4; ++m) {
                    const f32x4 g = acc[ai][0][m][n], v = acc[ai][1][m][n];
                    const f32x4 rg1 = dpp4<0x121>(g), rg2 = dpp4<0x122>(g), rv1 = dpp4<0x121>(v), rv2 = dpp4<0x122>(v);
                    const f32x4 g1 = fr >= 1 ? rg1 : pg1, g2 = fr >= 2 ? rg2 : pg2, v1 = fr >= 1 ? rv1 : pv1, v2 = fr >= 2 ? rv2 : pv2;
                    const f32x4 cg_ = wg2 * g + wg1 * g1 + wg0 * g2, cv_ = wv2 * v + wv1 * v1 + wv0 * v2;
                    f32x4 o; o.x = silu_f(cg_.x) * cv_.x; o.y = silu_f(cg_.y) * cv_.y; o.z = silu_f(cg_.z) * cv_.z; o.w = silu_f(cg_.w) * cv_.w;
                    const int row = u.row0 + 128 * ai + 64 * wr + 16 * m + fr;
                    st_bf4(act + (size_t)row * FF + ch, o);
                    pg1 = rg1; pg2 = rg2; pv1 = rv1; pv2 = rv2;
                } } }
    }
};
}

__device__ __forceinline__ void transpose_item(const float* W, int K, int N, bf16_t* WT, const float* gain, int mode, LAS float* scr, int item, int lane) {
    const int nblk = (N + 31) / 32, kb = item / nblk, nb = item % nblk, k0 = 64 * kb, n0 = 32 * nb;
    const int nn = n0 + (lane & 31); const bool inb = nn < N;
    const float* src = W + (size_t)(k0 + (lane >> 5)) * N + (inb ? nn : N - 1);
    float v[32];
#pragma unroll
    for (int i = 0; i < 32; ++i) v[i] = src[(size_t)(2 * i) * N];
    const int c = lane & 7;
    f32x4 g0 = (f32x4){1.f, 1.f, 1.f, 1.f}, g1 = g0;
    if (gain) { g0 = *(const f32x4*)(gain + k0 + 8 * c); g1 = *(const f32x4*)(gain + k0 + 8 * c + 4); }
#pragma unroll
    for (int i = 0; i < 32; ++i) scr[(2 * i + (lane >> 5)) * 33 + (lane & 31)] = inb ? v[i] : 0.f;
    asm volatile("s_waitcnt lgkmcnt(0)" ::: "memory");
    int rbase = n0;
    if (mode == 1) { const int isv = n0 >= FF ? 1 : 0; const int ch = n0 - isv * FF; rbase = (ch >> 7) * 256 + isv * 128 + (ch & 127); }
#pragma unroll
    for (int j = 0; j < 4; ++j) { const int n = (lane >> 3) + 8 * j; const LAS float* s = scr + (8 * c) * 33 + n;
        u32x4 o; o.x = pk2(s[0 * 33] * g0.x, s[1 * 33] * g0.y); o.y = pk2(s[2 * 33] * g0.z, s[3 * 33] * g0.w); o.z = pk2(s[4 * 33] * g1.x, s[5 * 33] * g1.y); o.w = pk2(s[6 * 33] * g1.z, s[7 * 33] * g1.w);
        *(u32x4*)(WT + (size_t)(rbase + n) * K + k0 + 8 * c) = o; }
    asm volatile("s_waitcnt lgkmcnt(0)" ::: "memory");
}

__device__ __forceinline__ void s5_unit_consts(const Params& p, int g, int lane, float& lbr, float& lbi, f32x4 (&frag)[8]);
__device__ __forceinline__ void phase_prologue(const Params& p, LAS unsigned char* lds, int G) {
    const int tid = fresh_tid(), lane = tid & 63, wave = tid >> 6;
    LAS float* scr = (LAS float*)(lds + wave * 16384);
    const int gw = blockIdx.x * 8 + wave, NGW = G * 8;
    unsigned char* ws = p.ws;
    constexpr int NI0 = 16 * 81, NI1 = 8 * 16, NI2 = 16 * 32, NI3 = 16 * 32, NI5 = 16 * 64, NI9 = 16 * 176, NI11 = 44 * 32, NI13 = 4 * 8;
    constexpr int C1 = NI0, C2 = C1 + NI1, C3 = C2 + NI2, C4 = C3 + NI3, C5 = C4 + NI3, C6 = C5 + NI5, C7 = C6 + NI5, C8 = C7 + NI3, C9 = C8 + NI3, C10 = C9 + NI9, C11 = C10 + NI9, C12 = C11 + NI11, C13 = C12 + NI11, CEND = C13 + 4 * NI13;
    for (int gi = gw; gi < CEND; gi += NGW) {
        const float* W; int K, N, mode = 0, it; bf16_t* WT; const float* gain = nullptr;
        if (gi < C1) { it = gi; W = p.in[7]; K = 1024; N = NIN; WT = (bf16_t*)(ws + O_WIN); gain = p.in[2]; }
        else if (gi < C2) { it = gi - C1; W = p.in[20]; K = 512; N = 512; WT = (bf16_t*)(ws + O_WGLU); }
        else if (gi < C3) { it = gi - C2; W = p.in[22]; K = 1024; N = 1024; WT = (bf16_t*)(ws + O_WOUT); }
        else if (gi < C5) { const int l = gi >= C4; it = gi - (l ? C4 : C3); W = p.in[25] + l * 1048576; K = 1024; N = 1024; WT = (bf16_t*)(ws + O_WQ) + l * 1048576; gain = p.in[3] + l * 1024; }
        else if (gi < C7) { const int l = gi >= C6; it = gi - (l ? C6 : C5); W = p.in[26] + l * 2097152; K = 1024; N = 2048; WT = (bf16_t*)(ws + O_WKV) + l * 2097152; }
        else if (gi < C9) { const int l = gi >= C8; it = gi - (l ? C8 : C7); W = p.in[27] + l * 1048576; K = 1024; N = 1024; WT = (bf16_t*)(ws + O_WO) + l * 1048576; }
        else if (gi < C11) { const int l = gi >= C10; it = gi - (l ? C10 : C9); W = p.in[28] + (size_t)l * 1024 * FF2; K = 1024; N = FF2; WT = (bf16_t*)(ws + O_WUP) + (size_t)l * FF2 * 1024; gain = p.in[4] + l * 1024; mode = 1; }
        else if (gi < C13) { const int l = gi >= C12; it = gi - (l ? C12 : C11); W = p.in[30] + (size_t)l * FF * 1024; K = FF; N = 1024; WT = (bf16_t*)(ws + O_WDN) + (size_t)l * 1024 * FF; }
        else { const int q = (gi - C13) / NI13; it = gi - C13 - q * NI13; W = p.in[23] + q * 65536; K = 256; N = 256; WT = (bf16_t*)(ws + O_POOL) + q * 65536; }
        transpose_item(W, K, N, WT, gain, mode, scr, it, lane);
    }
    { u32x4* z = (u32x4*)((bf16_t*)(ws + O_WIN) + (size_t)2592 * 1024); const int n16 = 224 * 1024 * 2 / 16;
      for (int i = blockIdx.x * 512 + tid; i < n16; i += G * 512) z[i] = (u32x4){0u, 0u, 0u, 0u}; }
    { float* s = (float*)(ws + O_SSQ) + MT; for (int i = blockIdx.x * 512 + tid; i < 6 * MT; i += G * 512) __hip_atomic_store(s + i, 0.f, __ATOMIC_RELAXED, __HIP_MEMORY_SCOPE_AGENT); }
    for (int g = gw; g < 32; g += NGW) {
        float lbr, lbi; f32x4 frag[8]; s5_unit_consts(p, g, lane, lbr, lbi, frag);
        f32x4* tf = (f32x4*)(ws + O_XPREV) + (size_t)g * 512 + lane;
#pragma unroll
        for (int k = 0; k < 8; ++k) tf[64 * k] = frag[k];
        float* tl = (float*)(ws + O_XPREV + 262144) + ((size_t)g * 64 + lane) * 2; tl[0] = lbr; tl[1] = lbi;
    }
    for (int r = gw; r < 2048; r += NGW) {
        const f32x4* xr = (const f32x4*)(p.in[1] + (size_t)r * 1024) + lane; const f32x4* gr = (const f32x4*)p.in[5] + lane;
        f32x4 v[4]; float s = 0.f;
#pragma unroll
        for (int j = 0; j < 4; ++j) { v[j] = xr[64 * j]; s += (v[j].x * v[j].x + v[j].y * v[j].y) + (v[j].z * v[j].z + v[j].w * v[j].w); }
        const float rs = rsqrtf(wave_sum(s) * (1.0f / 1024.0f) + EPS);
        bf16_t* o = (bf16_t*)(ws + O_MEMN) + (size_t)r * 1024;
#pragma unroll
        for (int j = 0; j < 4; ++j) pg8::st_bf4(o + (64 * j + lane) * 4, v[j] * rs * gr[64 * j]);
    }
    for (int r = gw; r < MT; r += NGW) {
        const f32x4* xr = (const f32x4*)(p.in[0] + (size_t)r * 1024) + lane;
        bf16_t* o = (bf16_t*)(ws + O_XB) + (size_t)r * 1024; float s = 0.f;
#pragma unroll
        for (int j = 0; j < 4; ++j) { const f32x4 v = xr[64 * j]; pg8::st_bf4(o + (64 * j + lane) * 4, v); s += (v.x * v.x + v.y * v.y) + (v.z * v.z + v.w * v.w); }
        s = wave_sum(s); if (lane == 0) ((float*)(ws + O_SSQ))[r] = s;
    }
}

__device__ __forceinline__ void delta_prep(const Params& p, LAS unsigned char* lds, int chunk) {
    const int tid = fresh_tid(), lane = tid & 63, wave = tid >> 6;
    const int c = chunk & 31, bh = chunk >> 5, h = bh & 3, b = bh >> 2;
    const int row0 = b * SEQ + c * 64;
    LAS float* qf = (LAS float*)lds;
    LAS float* kf = qf + 64 * 132;
    LAS float* vf = kf + 64 * 132;
    LAS float* Am = vf + 64 * 132;
    LAS float* gc = Am + 64 * 68;
    LAS float* bt = gc + 64;
    LAS float* Tinv = bt + 64;
    unsigned char* ws = p.ws;
    const bf16_t* raw = (const bf16_t*)(ws + O_QKVRAW);
    if (tid < 384) {
        const int quad = tid % 96, seg = tid / 96, part = quad >> 5, within = (quad & 31) * 4, gcol = part * 512 + h * 128 + within;
        const float* cwp = p.in[8] + gcol;
        const f32x4 w0 = *(const f32x4*)cwp, w1 = *(const f32x4*)(cwp + 1536), w2 = *(const f32x4*)(cwp + 3072), w3 = *(const f32x4*)(cwp + 4608);
        LAS float* dst = (part == 0 ? qf : (part == 1 ? kf : vf)) + within;
        const int t0 = seg * 16;
        u32x2 rw[19];
#pragma unroll
        for (int k = 0; k < 19; ++k) { const int t = t0 - 3 + k; const int tc = (c * 64 + t >= 0) ? t : 0; rw[k] = *(const u32x2*)(raw + (size_t)(row0 + tc) * 1536 + gcol); }
        f32x4 xs[19];
#pragma unroll
        for (int k = 0; k < 19; ++k) { const bool ok = (c * 64 + t0 - 3 + k >= 0); xs[k] = ok ? (f32x4){bflo(rw[k].x), bfhi(rw[k].x), bflo(rw[k].y), bfhi(rw[k].y)} : (f32x4){0.f, 0.f, 0.f, 0.f}; }
#pragma unroll
        for (int i = 0; i < 16; ++i) {
            const f32x4 y = w0 * xs[i] + w1 * xs[i + 1] + w2 * xs[i + 2] + w3 * xs[i + 3];
            f32x4 o; o.x = silu_f(y.x); o.y = silu_f(y.y); o.z = silu_f(y.z); o.w = silu_f(y.w);
            *(LAS f32x4*)(dst + (t0 + i) * 132) = o;
        }
    } else if (wave == 6) {
        const float* ba = (const float*)(ws + O_BA) + (size_t)(row0 + lane) * 8;
        const float al = ba[4 + h] + p.in[10][h]; const float sp = al > 20.f ? al : log1pf(expf(al));
        float g = -expf(p.in[9][h]) * sp;
#pragma unroll
        for (int o = 1; o < 64; o <<= 1) { const float t = __shfl_up(g, o); if (lane >= o) g += t; }
        gc[lane] = g; bt[lane] = sigmoid_f(ba[h]);
        if (lane == 63) ((float*)(ws + O_GL))[chunk] = expf(g);
    }
    LDS_BARRIER();
    {
        const int r = tid >> 2, qr = tid & 3; LAS float* rp = (r < 64 ? qf + r * 132 : kf + (r - 64) * 132) + qr * 32;
        f32x4 v[8]; float s = 0.f;
#pragma unroll
        for (int j = 0; j < 8; ++j) { v[j] = *(const LAS f32x4*)(rp + 4 * j); s += (v[j].x * v[j].x + v[j].y * v[j].y) + (v[j].z * v[j].z + v[j].w * v[j].w); }
        s += __shfl_xor(s, 1); s += __shfl_xor(s, 2);
        const float sc = rsqrtf(s + 1e-6f) * (r < 64 ? 0.08838834764831845f : 1.0f);
#pragma unroll
        for (int j = 0; j < 8; ++j) *(LAS f32x4*)(rp + 4 * j) = v[j] * sc;
    }
    LDS_BARRIER();
    bf16_t* dp2 = (bf16_t*)(ws + O_DP2 + (size_t)chunk * 40960);
    bf16_t* dp1 = (bf16_t*)(ws + O_DP1 + (size_t)chunk * 32768);
    for (int job = wave; job < 32; job += 8) {
        const int isqk = job >> 4, ti = (job >> 2) & 3, tj = job & 3;
        const int fr = lane & 15, fq = lane >> 4;
        const LAS float* ap = (isqk ? qf : kf) + (16 * ti + fr) * 132 + fq;
        const LAS float* bp = kf + (16 * tj + fr) * 132 + fq;
        f32x4 acc = (f32x4){0.f, 0.f, 0.f, 0.f};
#pragma unroll 8
        for (int ks = 0; ks < 32; ++ks) acc = __builtin_amdgcn_mfma_f32_16x16x4f32(ap[4 * ks], bp[4 * ks], acc, 0, 0, 0);
        const int j = 16 * tj + fr; const float gj = gc[j];
#pragma unroll
        for (int r = 0; r < 4; ++r) { const int i = 16 * ti + 4 * fq + r; const float dec = __expf(gc[i] - gj);
            if (!isqk) { Am[i * 68 + j] = (j < i) ? acc[r] * dec * bt[i] : 0.f; }
            else { const float v = (j <= i) ? acc[r] * dec : 0.f;
                const int mt = i >> 4, ii = i & 15, ks2 = j >> 5, r32 = j & 31, jj = 4 * (r32 >> 4) + (r32 & 3), q = (r32 & 15) >> 2;
                dp2[16384 + ((mt * 2 + ks2) * 64 + ii + 16 * q) * 8 + jj] = (bf16_t)f2bf(v); } }
    }
    LDS_BARRIER();
    if (wave == 0) {
        const int b = lane >> 4, j = lane & 15; float t[16];
#pragma unroll
        for (int i = 0; i < 16; ++i) {
            const LAS f32x4* ar = (const LAS f32x4*)(Am + (16 * b + i) * 68 + 16 * b);
            float sacc = (i == j) ? 1.f : 0.f;
#pragma unroll
            for (int k4 = 0; k4 < (i + 3) / 4; ++k4) { const f32x4 a = ar[k4];
                if (4 * k4 + 0 < i) sacc -= a.x * t[4 * k4 + 0]; if (4 * k4 + 1 < i) sacc -= a.y * t[4 * k4 + 1];
                if (4 * k4 + 2 < i) sacc -= a.z * t[4 * k4 + 2]; if (4 * k4 + 3 < i) sacc -= a.w * t[4 * k4 + 3]; }
            t[i] = sacc; Tinv[(b * 16 + i) * 16 + j] = sacc;
        }
    } else {
        const float gl = gc[63];
#pragma unroll 1
        for (int f = tid - 64; f < 1024; f += 448) {
            const int ln = f & 63, ii = ln & 15, q = ln >> 4;
            {
                const int mt = f >> 8, ks = (f >> 6) & 3, i = 16 * mt + ii; const float e = __expf(gc[i]);
                const LAS float* sp = qf + i * 132 + 32 * ks + 4 * q; const f32x4 lo = *(const LAS f32x4*)sp, hi = *(const LAS f32x4*)(sp + 16);
                u32x4 o; o.x = pk2(lo.x * e, lo.y * e); o.y = pk2(lo.z * e, lo.w * e); o.z = pk2(hi.x * e, hi.y * e); o.w = pk2(hi.z * e, hi.w * e);
                *(u32x4*)(dp2 + (size_t)f * 8) = o; }
            {
                const int mt8 = f >> 7, ks2 = (f >> 6) & 1, dk = 16 * mt8 + ii; float v[8];
#pragma unroll
                for (int jj = 0; jj < 8; ++jj) { const int sidx = 32 * ks2 + 16 * (jj >> 2) + 4 * q + (jj & 3); v[jj] = kf[sidx * 132 + dk] * __expf(gl - gc[sidx]); }
                u32x4 o; o.x = pk2(v[0], v[1]); o.y = pk2(v[2], v[3]); o.z = pk2(v[4], v[5]); o.w = pk2(v[6], v[7]);
                *(u32x4*)(dp2 + 8192 + (size_t)f * 8) = o; }
        }
    }
    LDS_BARRIER();
    {
        const int fr = lane & 15, fq = lane >> 4;
#pragma unroll 1
        for (int nt2 = 0; nt2 < 2; ++nt2) {
            const int col = 32 * wave + 16 * nt2 + fr; const bool isw = wave >= 4;
            LAS float* buf = isw ? kf + (col - 128) : vf + col;
            f32x4 X[4];
#pragma unroll
            for (int b = 0; b < 4; ++b) {
                f32x4 acc = (f32x4){0.f, 0.f, 0.f, 0.f};
#pragma unroll
                for (int b2 = 0; b2 < b; ++b2) { const f32x4 a = *(const LAS f32x4*)(Am + (16 * b + fr) * 68 + 16 * b2 + 4 * fq);
                    acc = __builtin_amdgcn_mfma_f32_16x16x4f32(a.x, X[b2].x, acc, 0, 0, 0); acc = __builtin_amdgcn_mfma_f32_16x16x4f32(a.y, X[b2].y, acc, 0, 0, 0);
                    acc = __builtin_amdgcn_mfma_f32_16x16x4f32(a.z, X[b2].z, acc, 0, 0, 0); acc = __builtin_amdgcn_mfma_f32_16x16x4f32(a.w, X[b2].w, acc, 0, 0, 0); }
                f32x4 R;
#pragma unroll
                for (int r = 0; r < 4; ++r) { const int row = 16 * b + 4 * fq + r; float v = buf[row * 132] * bt[row]; if (isw) v *= __expf(gc[row]); R[r] = v - acc[r]; }
                const f32x4 tv = *(const LAS f32x4*)(Tinv + (b * 16 + fr) * 16 + 4 * fq);
                f32x4 xb = (f32x4){0.f, 0.f, 0.f, 0.f};
                xb = __builtin_amdgcn_mfma_f32_16x16x4f32(tv.x, R.x, xb, 0, 0, 0); xb = __builtin_amdgcn_mfma_f32_16x16x4f32(tv.y, R.y, xb, 0, 0, 0);
                xb = __builtin_amdgcn_mfma_f32_16x16x4f32(tv.z, R.z, xb, 0, 0, 0); xb = __builtin_amdgcn_mfma_f32_16x16x4f32(tv.w, R.w, xb, 0, 0, 0);
                X[b] = xb;
#pragma unroll
                for (int r = 0; r < 4; ++r) buf[(16 * b + 4 * fq + r) * 132] = xb[r];
            }
        }
    }
    LDS_BARRIER();
#pragma unroll 1
    for (int f = tid; f < 1024; f += 512) {
        { const int i = f >> 4, c8 = (f & 15) * 8; const LAS float* s = vf + i * 132 + c8; const f32x4 lo = *(const LAS f32x4*)s, hi = *(const LAS f32x4*)(s + 4);
          u32x4 o; o.x = pk2(lo.x, lo.y); o.y = pk2(lo.z, lo.w); o.z = pk2(hi.x, hi.y); o.w = pk2(hi.z, hi.w);
          *(u32x4*)(dp1 + 8192 + i * 128 + c8) = o; }
        { const int ln = f & 63, ii = ln & 15, q = ln >> 4, mt = f >> 8, ks = (f >> 6) & 3, i = 16 * mt + ii;
          const LAS float* s = kf + i * 132 + 32 * ks + 4 * q; const f32x4 lo = *(const LAS f32x4*)s, hi = *(const LAS f32x4*)(s + 16);
          u32x4 o; o.x = pk2(lo.x, lo.y); o.y = pk2(lo.z, lo.w); o.z = pk2(hi.x, hi.y); o.w = pk2(hi.z, hi.w);
          *(u32x4*)(dp1 + (size_t)f * 8) = o; }
    }
    LDS_BARRIER();
}

constexpr int SCAN_BUF = 59392;
__device__ __forceinline__ void scan_compute(LAS unsigned char* cur, f32x4 (&S)[8], float gl, float* orow, int lane) {
    const int fr = lane & 15, fq = lane >> 4;
    const LAS bf16x8* wf = (const LAS bf16x8*)cur + lane; const LAS bf16x8* qg = wf + 1024; const LAS bf16x8* kd = wf + 2048; const LAS bf16x8* qk = wf + 3072;
    const LAS bf16_t* uu = (const LAS bf16_t*)(cur + 57344);
    bf16x8 bS[4];
#pragma unroll
    for (int ks = 0; ks < 4; ++ks) { u32x4 w; w.x = pk2(S[2 * ks].x, S[2 * ks].y); w.y = pk2(S[2 * ks].z, S[2 * ks].w); w.z = pk2(S[2 * ks + 1].x, S[2 * ks + 1].y); w.w = pk2(S[2 * ks + 1].z, S[2 * ks + 1].w); bS[ks] = __builtin_bit_cast(bf16x8, w); }
    f32x4 vn[4], o[4];
#pragma unroll
    for (int mt = 0; mt < 4; ++mt) {
        f32x4 a = (f32x4){0.f, 0.f, 0.f, 0.f}, q = a;
#pragma unroll
        for (int ks = 0; ks < 4; ++ks) { a = __builtin_amdgcn_mfma_f32_16x16x32_bf16(wf[(mt * 4 + ks) * 64], bS[ks], a, 0, 0, 0); q = __builtin_amdgcn_mfma_f32_16x16x32_bf16(qg[(mt * 4 + ks) * 64], bS[ks], q, 0, 0, 0); }
        f32x4 uv;
#pragma unroll
        for (int r = 0; r < 4; ++r) uv[r] = bf1(uu[(16 * mt + 4 * fq + r) * 16 + fr]);
        vn[mt] = uv - a; o[mt] = q;
        __builtin_amdgcn_sched_barrier(0);
    }
    __builtin_amdgcn_sched_barrier(0);
    bf16x8 bV[2];
#pragma unroll
    for (int ks = 0; ks < 2; ++ks) { u32x4 w; w.x = pk2(vn[2 * ks].x, vn[2 * ks].y); w.y = pk2(vn[2 * ks].z, vn[2 * ks].w); w.z = pk2(vn[2 * ks + 1].x, vn[2 * ks + 1].y); w.w = pk2(vn[2 * ks + 1].z, vn[2 * ks + 1].w); bV[ks] = __builtin_bit_cast(bf16x8, w); }
#pragma unroll
    for (int m8 = 0; m8 < 8; ++m8) {
        f32x4 sv = S[m8] * gl;
#pragma unroll
        for (int ks = 0; ks < 2; ++ks) sv = __builtin_amdgcn_mfma_f32_16x16x32_bf16(kd[(m8 * 2 + ks) * 64], bV[ks], sv, 0, 0, 0);
        S[m8] = sv;
        if (m8 & 1) __builtin_amdgcn_sched_barrier(0);
    }
    __builtin_amdgcn_sched_barrier(0);
#pragma unroll
    for (int mt = 0; mt < 4; ++mt) {
#pragma unroll
        for (int ks = 0; ks < 2; ++ks) o[mt] = __builtin_amdgcn_mfma_f32_16x16x32_bf16(qk[(mt * 2 + ks) * 64], bV[ks], o[mt], 0, 0, 0);
#pragma unroll
        for (int r = 0; r < 4; ++r) orow[(size_t)(16 * mt + 4 * fq + r) * 512 + fr] = o[mt][r];
    }
}
__device__ __forceinline__ void s5_unit_consts(const Params& p, int g, int lane, float& lbr, float& lbi, f32x4 (&frag)[8]) {
    const int fr = lane & 15, fq = lane >> 4;
    const float dt = expf(p.in[19][g]); const float lr = p.in[12][g * 64 + lane], li = p.in[13][g * 64 + lane];
    const float mag = expf(lr * dt); float sn, cs; sincosf(li * dt, &sn, &cs); lbr = mag * cs; lbi = mag * sn;
    const float den = lr * lr + li * li, nr = lbr - 1.0f, ni = lbi; const float cr = (nr * lr + ni * li) / den, ci = (ni * lr - nr * li) / den;
    const float msk = fq < 2 ? 1.0f : 0.0f;
#pragma unroll
    for (int m4 = 0; m4 < 4; ++m4) {
        const int pm = 16 * m4 + fr; const float crs = __shfl(cr, pm) * msk, cis = __shfl(ci, pm) * msk;
        const float* brp = p.in[14] + (size_t)(g * 64 + pm) * 16 + 8 * (fq & 1); const float* bip = p.in[15] + (size_t)(g * 64 + pm) * 16 + 8 * (fq & 1);
        const f32x4 b0 = *(const f32x4*)brp, b1 = *(const f32x4*)(brp + 4), i0 = *(const f32x4*)bip, i1 = *(const f32x4*)(bip + 4);
        const f32x4 r0 = b0 * crs - i0 * cis, r1 = b1 * crs - i1 * cis, m0 = i0 * crs + b0 * cis, m1 = i1 * crs + b1 * cis;
        u32x4 wr_, wi_; wr_.x = pk2(r0.x, r0.y); wr_.y = pk2(r0.z, r0.w); wr_.z = pk2(r1.x, r1.y); wr_.w = pk2(r1.z, r1.w);
        wi_.x = pk2(m0.x, m0.y); wi_.y = pk2(m0.z, m0.w); wi_.z = pk2(m1.x, m1.y); wi_.w = pk2(m1.z, m1.w);
        frag[m4] = __builtin_bit_cast(f32x4, wr_); frag[m4 + 4] = __builtin_bit_cast(f32x4, wi_);
        asm volatile("" ::: "memory");
    }
}
constexpr int XSB_STRIDE = 136, XSB_BYTES = 16 * XSB_STRIDE * 2;
__device__ __forceinline__ u32x4 s5_u_load(const bf16_t* ub, int row16, int g, int lane) { return *(const u32x4*)(ub + (size_t)(row16 + (lane & 15)) * 512 + g * 16 + 8 * ((lane >> 4) & 1)); }
__device__ __forceinline__ void s5_bu_tile(u32x4 uf, int lane, const f32x4 (&frag)[8], LAS bf16_t* XSb) {
    const int fr = lane & 15, fq = lane >> 4;
    if (fq >= 2) uf = (u32x4){0u, 0u, 0u, 0u};
    const bf16x8 ufr = __builtin_bit_cast(bf16x8, uf);
#pragma unroll
    for (int mt = 0; mt < 8; ++mt) {
        const f32x4 a = __builtin_amdgcn_mfma_f32_16x16x32_bf16(__builtin_bit_cast(bf16x8, frag[mt]), ufr, (f32x4){0.f, 0.f, 0.f, 0.f}, 0, 0, 0);
        u32x2 w; w.x = pk2(a[0], a[1]); w.y = pk2(a[2], a[3]);
        *(LAS u32x2*)(XSb + fr * XSB_STRIDE + 16 * mt + 4 * fq) = w;
    }
    asm volatile("s_waitcnt lgkmcnt(0)" ::: "memory");
}
__device__ __forceinline__ void s5_consts(const Params& p, int g, int lane, float& lbr, float& lbi, float (&bbr)[16], float (&bbi)[16]);
#define S5_STEP(t) do { float bur = 0.f, bui = 0.f; \
    _Pragma("unroll") for (int k = 0; k < 8; ++k) { const unsigned w = (unsigned)__builtin_amdgcn_readlane((int)ur[k], (t)); const float u0 = bflo(w), u1 = bfhi(w); \
        bur += bbr[2 * k] * u0; bui += bbi[2 * k] * u0; bur += bbr[2 * k + 1] * u1; bui += bbi[2 * k + 1] * u1; } \
    const float nxr = lbr * xr - lbi * xi + bur, nxi = lbr * xi + lbi * xr + bui; xr = nxr; xi = nxi; } while (0)
__device__ __forceinline__ void delta_scan(const Params& p, LAS unsigned char* lds, int item, int G) {
    const int tid = fresh_tid(), lane = tid & 63, wave = __builtin_amdgcn_readfirstlane(tid >> 6), fr = lane & 15, fq = lane >> 4;
    const int bh = item >> 3, sl = item & 7, h = bh & 3, b = bh >> 2;
    unsigned char* ws = p.ws;
    float* od = (float*)(ws + O_ODELTA) + (size_t)(b * SEQ) * 512 + h * 128 + 16 * sl;
    const float* glp = (const float*)(ws + O_GL) + bh * 32;
#define SCAN_STAGE(c_, bufp_) do { const int chunk_ = bh * 32 + (c_); \
        const char* s1_ = (const char*)(ws + O_DP1 + (size_t)chunk_ * 32768) + (size_t)tid * 16; const char* s2_ = (const char*)(ws + O_DP2 + (size_t)chunk_ * 40960) + (size_t)tid * 16; \
        LAS unsigned char* d_ = (bufp_) + wave * 1024; \
        __builtin_amdgcn_global_load_lds((const unsigned*)s1_, (LAS unsigned*)d_, 16, 0, 0); \
        __builtin_amdgcn_global_load_lds((const unsigned*)(s1_ + 8192), (LAS unsigned*)(d_ + 8192), 16, 0, 0); \
        _Pragma("unroll") for (int k_ = 0; k_ < 5; ++k_) __builtin_amdgcn_global_load_lds((const unsigned*)(s2_ + 8192 * k_), (LAS unsigned*)(d_ + 16384 + 8192 * k_), 16, 0, 0); \
        if (wave < 2) __builtin_amdgcn_global_load_lds((const unsigned*)(ws + O_DP1 + (size_t)chunk_ * 32768 + 16384 + (size_t)(tid >> 1) * 256 + sl * 32 + (tid & 1) * 16), (LAS unsigned*)(d_ + 57344), 16, 0, 0); } while (0)
    int s5_un = item * 7 + (wave - 1); const int s5_stride = G * 7; int s5_sc = 0;
    float lbr = 0.f, lbi = 0.f, xr = 0.f, xi = 0.f;
    f32x4 S[8];
    int s5_rowb = 0, s5_g = 0;
    LAS bf16_t* XSb = (LAS bf16_t*)(lds + 2 * SCAN_BUF + (wave > 0 ? wave - 1 : 0) * XSB_BYTES);
    const bf16_t* ub = (const bf16_t*)(ws + O_U); bf16_t* yg = (bf16_t*)(ws + O_YG);
#define S5_SUB() do { if (s5_un < 8192) { \
        if (s5_sc == 0) { const int c_ = s5_un & 31; s5_g = (s5_un >> 5) & 31; const int b_ = s5_un >> 10; s5_rowb = b_ * SEQ + c_ * 64; \
            { const f32x4* tf_ = (const f32x4*)(ws + O_XPREV) + (size_t)s5_g * 512 + lane; _Pragma("unroll") for (int k_ = 0; k_ < 8; ++k_) S[k_] = tf_[64 * k_]; \
              const float* tl_ = (const float*)(ws + O_XPREV + 262144) + ((size_t)s5_g * 64 + lane) * 2; lbr = tl_[0]; lbi = tl_[1]; } \
            xr = 0.f; xi = 0.f; \
            { float ar_ = lbr, ai_ = lbi; \
              _Pragma("unroll") for (int k_ = 0; k_ < 6; ++k_) { const float nr_ = ar_ * ar_ - ai_ * ai_, ni_ = 2.0f * ar_ * ai_; ar_ = nr_; ai_ = ni_; } \
              const float* xe_ = (const float*)(ws + O_XEND) + ((size_t)(s5_un - c_) * 64 + lane) * 2; \
              float er_[31], ei_[31]; \
              _Pragma("unroll") for (int k_ = 0; k_ < 31; ++k_) { const int cc_ = k_ < c_ ? k_ : 0; const float2 e_ = *(const float2*)(xe_ + cc_ * 128); er_[k_] = e_.x; ei_[k_] = e_.y; } \
              _Pragma("unroll") for (int k_ = 0; k_ < 31; ++k_) { if (k_ < c_) { const float nr_ = ar_ * xr - ai_ * xi + er_[k_], ni_ = ar_ * xi + ai_ * xr + ei_[k_]; xr = nr_; xi = ni_; } } } \
        } \
        const int row_ = s5_rowb + s5_sc * 16 + fr; \
        const u32x2 uw_ = *(const u32x2*)(ub + (size_t)row_ * 512 + s5_g * 16 + 4 * fq); \
        bf16x8 ccf[4]; f32x4 dd; \
        _Pragma("unroll") for (int ks_ = 0; ks_ < 4; ++ks_) { const float* cp_ = (ks_ < 2 ? p.in[16] : p.in[17]) + (size_t)(s5_g * 16 + fr) * 64 + (32 * ks_ & 63) + 8 * fq; \
            const f32x4 lo_ = *(const f32x4*)cp_, hi_ = *(const f32x4*)(cp_ + 4); const float sg_ = ks_ < 2 ? 1.f : -1.f; u32x4 w_; \
            w_.x = pk2(lo_.x * sg_, lo_.y * sg_); w_.y = pk2(lo_.z * sg_, lo_.w * sg_); w_.z = pk2(hi_.x * sg_, hi_.y * sg_); w_.w = pk2(hi_.z * sg_, hi_.w * sg_); ccf[ks_] = __builtin_bit_cast(bf16x8, w_); } \
        dd = *(const f32x4*)(p.in[18] + s5_g * 16 + 4 * fq); \
        s5_bu_tile(s5_u_load(ub, s5_rowb + s5_sc * 16, s5_g, lane), lane, S, XSb); \
        _Pragma("unroll 4") for (int t16_ = 0; t16_ < 16; ++t16_) { const float bur_ = bf1(XSb[t16_ * XSB_STRIDE + lane]), bui_ = bf1(XSb[t16_ * XSB_STRIDE + 64 + lane]); \
            const float nxr_ = lbr * xr - lbi * xi + bur_, nxi_ = lbr * xi + lbi * xr + bui_; xr = nxr_; xi = nxi_; \
            { const unsigned w2_ = pk2(xr, xi); XSb[t16_ * XSB_STRIDE + lane] = (bf16_t)w2_; XSb[t16_ * XSB_STRIDE + 64 + lane] = (bf16_t)(w2_ >> 16); } } \
        asm volatile("s_waitcnt lgkmcnt(0)" ::: "memory"); \
        f32x4 acc_ = (f32x4){0.f, 0.f, 0.f, 0.f}; \
        _Pragma("unroll") for (int ks_ = 0; ks_ < 4; ++ks_) acc_ = __builtin_amdgcn_mfma_f32_16x16x32_bf16(ccf[ks_], *(const LAS bf16x8*)(XSb + fr * XSB_STRIDE + 32 * ks_ + 8 * fq), acc_, 0, 0, 0); \
        f32x4 y_; y_.x = acc_[0] + dd.x * bflo(uw_.x); y_.y = acc_[1] + dd.y * bfhi(uw_.x); y_.z = acc_[2] + dd.z * bflo(uw_.y); y_.w = acc_[3] + dd.w * bfhi(uw_.y); \
        y_.x = gelu_tanh(y_.x); y_.y = gelu_tanh(y_.y); y_.z = gelu_tanh(y_.z); y_.w = gelu_tanh(y_.w); \
        pg8::st_bf4(yg + (size_t)row_ * 512 + s5_g * 16 + 4 * fq, y_); \
        asm volatile("s_waitcnt lgkmcnt(0)" ::: "memory"); \
        if (++s5_sc == 4) { s5_sc = 0; s5_un += s5_stride; } } } while (0)
#pragma unroll
    for (int i = 0; i < 8; ++i) S[i] = (f32x4){0.f, 0.f, 0.f, 0.f};
    SCAN_STAGE(0, lds);
    WG_BARRIER();
#pragma unroll 1
    for (int c = 0; c < 32; ++c) {
        LAS unsigned char* cur = lds + (c & 1) * SCAN_BUF; LAS unsigned char* nxt = lds + ((c + 1) & 1) * SCAN_BUF;
        if (c + 1 < 32) SCAN_STAGE(c + 1, nxt);
        if (wave == 0) scan_compute(cur, S, glp[c], od + (size_t)(c * 64) * 512, lane); else S5_SUB();
        WG_BARRIER();
    }
    if (wave != 0) { while (s5_un < 8192) S5_SUB(); }
#undef SCAN_STAGE
#undef S5_SUB
}

struct S5C { float lbr, lbi; float bbr[16], bbi[16]; };
__device__ __forceinline__ void s5_consts(const Params& p, int g, int lane, float& lbr, float& lbi, float (&bbr)[16], float (&bbi)[16]) {
    const float dt = expf(p.in[19][g]); const float lr = p.in[12][g * 64 + lane], li = p.in[13][g * 64 + lane];
    const float mag = expf(lr * dt); float sn, cs; sincosf(li * dt, &sn, &cs); lbr = mag * cs; lbi = mag * sn;
    const float den = lr * lr + li * li, nr = lbr - 1.0f, ni = lbi; const float cr = (nr * lr + ni * li) / den, ci = (ni * lr - nr * li) / den;
    const f32x4* br4 = (const f32x4*)(p.in[14] + (size_t)(g * 64 + lane) * 16); const f32x4* bi4 = (const f32x4*)(p.in[15] + (size_t)(g * 64 + lane) * 16);
#pragma unroll
    for (int q = 0; q < 4; ++q) { const f32x4 br = br4[q], bi = bi4[q];
#pragma unroll
        for (int k = 0; k < 4; ++k) { bbr[4 * q + k] = cr * br[k] - ci * bi[k]; bbi[4 * q + k] = cr * bi[k] + ci * br[k]; } }
}
__device__ __forceinline__ void s5_pass1(const Params& p, LAS unsigned char* lds, int unit) {
    const int tid2 = fresh_tid(); const int lane = tid2 & 63, wave = tid2 >> 6; const int c = unit & 31, g = (unit >> 5) & 31, b = unit >> 10;
    LAS bf16_t* XSb = (LAS bf16_t*)(lds + wave * XSB_BYTES);
    const bf16_t* ub = (const bf16_t*)(p.ws + O_U); const int rowb = b * SEQ + c * 64;
    u32x4 uf[4];
#pragma unroll
    for (int sc = 0; sc < 4; ++sc) uf[sc] = s5_u_load(ub, rowb + sc * 16, g, lane);
    float lbr, lbi; f32x4 frag[8];
    { const f32x4* tf = (const f32x4*)(p.ws + O_XPREV) + (size_t)g * 512 + lane;
#pragma unroll
      for (int k = 0; k < 8; ++k) frag[k] = tf[64 * k];
      const float* tl = (const float*)(p.ws + O_XPREV + 262144) + ((size_t)g * 64 + lane) * 2; lbr = tl[0]; lbi = tl[1]; }
    float xr = 0.f, xi = 0.f;
#pragma unroll
    for (int sc = 0; sc < 4; ++sc) {
        s5_bu_tile(uf[sc], lane, frag, XSb);
#pragma unroll 4
        for (int t = 0; t < 16; ++t) { const float bur = bf1(XSb[t * XSB_STRIDE + lane]), bui = bf1(XSb[t * XSB_STRIDE + 64 + lane]);
            const float nxr = lbr * xr - lbi * xi + bur, nxi = lbr * xi + lbi * xr + bui; xr = nxr; xi = nxi; }
        asm volatile("s_waitcnt lgkmcnt(0)" ::: "memory");
    }
    float* xe = (float*)(p.ws + O_XEND) + ((size_t)unit * 64 + lane) * 2; xe[0] = xr; xe[1] = xi;
}
__device__ __forceinline__ void s5_combine(const Params& p, int idx) {
    const int pp = idx & 63, g = (idx >> 6) & 31, b = idx >> 11;
    const float dt = expf(p.in[19][g]); const float lr = p.in[12][g * 64 + pp], li = p.in[13][g * 64 + pp];
    const float mag = expf(lr * dt); float sn, cs; sincosf(li * dt, &sn, &cs); float ar = mag * cs, ai = mag * sn;
#pragma unroll
    for (int k = 0; k < 6; ++k) { const float nr = ar * ar - ai * ai, ni = 2.0f * ar * ai; ar = nr; ai = ni; }
    float xr = 0.f, xi = 0.f;
    const float* xe = (const float*)(p.ws + O_XEND); float* xp = (float*)(p.ws + O_XPREV);
    for (int c = 0; c < 32; ++c) { const size_t o = (((size_t)(b * 32 + g) * 32 + c) * 64 + pp) * 2;
        xp[o] = xr; xp[o + 1] = xi; const float er = xe[o], ei = xe[o + 1];
        const float nr = ar * xr - ai * xi + er, ni = ar * xi + ai * xr + ei; xr = nr; xi = ni; }
}
__device__ __forceinline__ void s5_pass2(const Params& p, LAS unsigned char* lds, int unit) {
    const int tid2 = fresh_tid(); const int lane = tid2 & 63, wave = tid2 >> 6, fr = lane & 15, fq = lane >> 4;
    const int c = unit & 31, g = (unit >> 5) & 31, b = unit >> 10;
    LAS float* XS = (LAS float*)(lds + wave * 8448);
    float lbr, lbi, bbr[16], bbi[16]; s5_consts(p, g, lane, lbr, lbi, bbr, bbi);
    const int rowb = b * SEQ + c * 64;
    const bf16_t* ub = (const bf16_t*)(p.ws + O_U);
    const bf16_t* up = ub + (size_t)(rowb + lane) * 512 + g * 16;
    unsigned ur[8]; { const u32x4 a = *(const u32x4*)up, bq = *(const u32x4*)(up + 8); ur[0] = a.x; ur[1] = a.y; ur[2] = a.z; ur[3] = a.w; ur[4] = bq.x; ur[5] = bq.y; ur[6] = bq.z; ur[7] = bq.w; }
    float cc[32];
#pragma unroll
    for (int ks = 0; ks < 32; ++ks) { const int k = 4 * ks + fq; cc[ks] = ks < 16 ? p.in[16][(size_t)(g * 16 + fr) * 64 + k] : -p.in[17][(size_t)(g * 16 + fr) * 64 + (k - 64)]; }
    const f32x4 dd = *(const f32x4*)(p.in[18] + g * 16 + 4 * fq);
    float xr = 0.f, xi = 0.f;
    {
        float ar = lbr, ai = lbi;
#pragma unroll
        for (int k = 0; k < 6; ++k) { const float nr = ar * ar - ai * ai, ni = 2.0f * ar * ai; ar = nr; ai = ni; }
        const float* xe = (const float*)(p.ws + O_XEND) + ((size_t)(unit - c) * 64 + lane) * 2;
        for (int c2 = 0; c2 < c; ++c2) { const float er = xe[c2 * 128], ei = xe[c2 * 128 + 1]; const float nr = ar * xr - ai * xi + er, ni = ar * xi + ai * xr + ei; xr = nr; xi = ni; }
    }
    bf16_t* yg = (bf16_t*)(p.ws + O_YG);
#pragma unroll 1
    for (int sc = 0; sc < 4; ++sc) {
#pragma unroll 4
        for (int t16 = 0; t16 < 16; ++t16) { S5_STEP(sc * 16 + t16); XS[t16 * 130 + lane] = xr; XS[t16 * 130 + 64 + lane] = xi; }
        asm volatile("s_waitcnt lgkmcnt(0)" ::: "memory");
        f32x4 acc = (f32x4){0.f, 0.f, 0.f, 0.f};
#pragma unroll
        for (int ks = 0; ks < 32; ++ks) acc = __builtin_amdgcn_mfma_f32_16x16x4f32(cc[ks], XS[fr * 130 + 4 * ks + fq], acc, 0, 0, 0);
        const int row = rowb + sc * 16 + fr;
        const u32x2 uw = *(const u32x2*)(ub + (size_t)row * 512 + g * 16 + 4 * fq);
        f32x4 y; y.x = acc[0] + dd.x * bflo(uw.x); y.y = acc[1] + dd.y * bfhi(uw.x); y.z = acc[2] + dd.z * bflo(uw.y); y.w = acc[3] + dd.w * bfhi(uw.y);
        y.x = gelu_tanh(y.x); y.y = gelu_tanh(y.y); y.z = gelu_tanh(y.z); y.w = gelu_tanh(y.w);
        pg8::st_bf4(yg + (size_t)row * 512 + g * 16 + 4 * fq, y);
        asm volatile("s_waitcnt lgkmcnt(0)" ::: "memory");
    }
}

constexpr size_t O_BAR = 524288;
#define XB_TMO      128
#define XB_XCNT(j)  (256  + 64 * (j))
#define XB_XSUB(j)  (1280 + 64 * (j))
#define XB_XGEN(j)  (2304 + 64 * (j))
#define XB_TOP      3328
#define XB_TOPGEN   3392
#define XCD_BAR_WORDS 3456
#define XB_SPIN_CAP (1u << 22)
__device__ __forceinline__ unsigned xb_ld(unsigned* p)              { return __hip_atomic_load(p, __ATOMIC_RELAXED, __HIP_MEMORY_SCOPE_AGENT); }
__device__ __forceinline__ unsigned xb_add(unsigned* p, unsigned v) { return __hip_atomic_fetch_add(p, v, __ATOMIC_RELAXED, __HIP_MEMORY_SCOPE_AGENT); }
__device__ __forceinline__ unsigned xb_xcc_id() { return (unsigned)__builtin_amdgcn_s_getreg((3 << 11) | 20) & 0xFu; }
#define XB_SPIN(cond, bar) do { unsigned _sp = 0; while (cond) { __builtin_amdgcn_s_sleep(1); \
    if ((++_sp & 255u) == 0u) { if (xb_ld(&(bar)[XB_TMO])) break; if (_sp > XB_SPIN_CAP) { atomicAdd(&(bar)[XB_TMO], 1u); break; } } } } while (0)
struct XcdBarrier { unsigned* bar; unsigned x; volatile LAS unsigned* st; };
__device__ __forceinline__ XcdBarrier xcd_barrier_post(unsigned* bar, volatile LAS unsigned* st) {
    XcdBarrier b; b.bar = bar; b.x = xb_xcc_id(); b.st = st;
    if (threadIdx.x == 0) (void)xb_add(&bar[XB_XCNT(b.x)], 1u);
    return b;
}
__device__ __forceinline__ void xcd_barrier_complete(unsigned* bar, unsigned x, unsigned& nloc, unsigned& nx) {
    const unsigned G = gridDim.x * gridDim.y * gridDim.z;
    unsigned sum, cnt, mine, sp = 0u;
    for (;;) {
        sum = 0u; cnt = 0u; mine = 0u;
#pragma unroll
        for (unsigned j = 0; j < 16; ++j) { const unsigned c = xb_ld(&bar[XB_XCNT(j)]); sum += c; cnt += (c > 0u) ? 1u : 0u; mine = (j == x) ? c : mine; }
        if (sum == G) break;
        __builtin_amdgcn_s_sleep(1);
        if ((++sp & 255u) == 0u) { if (xb_ld(&bar[XB_TMO])) break; if (sp > XB_SPIN_CAP) { atomicAdd(&bar[XB_TMO], 1u); break; } }
    }
    nloc = mine > 0u ? mine : 1u; nx = cnt > 0u ? cnt : 1u;
}
__device__ __forceinline__ void xcd_barrier(const XcdBarrier& b) {
    asm volatile("s_waitcnt vmcnt(0)" ::: "memory");
    __syncthreads();
    if (threadIdx.x == 0) {
        unsigned* bar = b.bar;
        __builtin_amdgcn_s_waitcnt(0);
        unsigned nloc = b.st[0], nx = b.st[1];
        if (nloc == 0u) { xcd_barrier_complete(bar, b.x, nloc, nx); b.st[0] = nloc; b.st[1] = nx; }
        const unsigned old = xb_add(&bar[XB_XSUB(b.x)], 1u);
        const unsigned gen = old / nloc;
        if (old + 1u == (gen + 1u) * nloc) {
            __builtin_amdgcn_fence(__ATOMIC_RELEASE, "agent");
            asm volatile("s_waitcnt vmcnt(0)" ::: "memory");
            const unsigned og = xb_add(&bar[XB_TOP], 1u);
            const unsigned tg = og / nx;
            if (og + 1u == (tg + 1u) * nx) xb_add(&bar[XB_TOPGEN], 1u);
            else XB_SPIN(xb_ld(&bar[XB_TOPGEN]) == tg, bar);
            __builtin_amdgcn_fence(__ATOMIC_ACQUIRE, "agent");
            xb_add(&bar[XB_XGEN(b.x)], 1u);
            asm volatile("s_waitcnt vmcnt(0)" ::: "memory");
        } else {
            XB_SPIN(xb_ld(&bar[XB_XGEN(b.x)]) == gen, bar);
            __builtin_amdgcn_fence(__ATOMIC_ACQUIRE, "agent");
            asm volatile("s_waitcnt vmcnt(0)" ::: "memory");
        }
    }
    __syncthreads();
}

template <int ONLYT> __global__ void __launch_bounds__(512) fwd_kernel(Params p) {
    extern __shared__ __attribute__((aligned(16))) unsigned char lds_raw[];
    LAS unsigned char* lds = (LAS unsigned char*)lds_raw;
    cg::grid_group grid = cg::this_grid();
    const int G = gridDim.x, bx = blockIdx.x;
    unsigned char* ws = p.ws;
    float* SSQ = (float*)(ws + O_SSQ);
    float* X = p.out; bf16_t* XB = (bf16_t*)(ws + O_XB);

    volatile LAS unsigned* bst = (volatile LAS unsigned*)(lds + LDS_BYTES - 64);
    if (threadIdx.x < 2) bst[threadIdx.x] = 0u;
    __syncthreads();
    XcdBarrier xbar; xbar.bar = (unsigned*)(ws + O_BAR); xbar.x = 0; xbar.st = bst;
    if (ONLYT < 0) xbar = xcd_barrier_post((unsigned*)(ws + O_BAR), bst);
#ifndef PROBE_A
#define PROBE_A -1
#define PROBE_B -1
#endif
    unsigned long long* tsbuf = (unsigned long long*)(ws + O_BAR + 65536); int seam = 0;
#define STAMP() do { if (PROBE_A >= 0) { if (blockIdx.x == 0 && threadIdx.x == 0) tsbuf[seam] = __builtin_amdgcn_s_memrealtime(); ++seam; } } while (0)
#define GRID_SYNC() do { if (ONLYT < 0) xcd_barrier(xbar); STAMP(); } while (0)
    STAMP();
    if (PH(0)) phase_prologue(p, lds, G);
    if (ONLYT < 0) { if (p.l_lo < 0) grid.sync(); xcd_barrier(xbar); }
    STAMP();

    if (PH(1)) {
        pg8::SchedPlain S{(const char*)XB, (const char*)(ws + O_WIN), 1024, 1024, 64, 11, G, bx, 0, 256};
        pg8::EpiWin E{SSQ, (bf16_t*)(ws + O_QKVRAW), (bf16_t*)(ws + O_GATE), (float*)(ws + O_BA), (bf16_t*)(ws + O_U)};
        pg8::gemm_phase(lds, 1024, 1024, 1024, S, E);
        pg8::SchedKV S2{(const char*)(ws + O_MEMN), (const char*)(ws + O_WKV), 0, G == 256 ? bx - 192 : bx};
        pg8::EpiKV E2{(bf16_t*)(ws + O_KM), (bf16_t*)(ws + O_VT)};
        pg8::gemm_phase(lds, 1024, 1024, 1024, S2, E2);
    }
    GRID_SYNC();

    if (PH(2)) for (int ch = bx; ch < 1024; ch += G) delta_prep(p, lds, ch);
    if (PH(3)) for (int un = bx * 8 + (fresh_tid() >> 6); un < 8192; un += G * 8) s5_pass1(p, lds, un);
    GRID_SYNC();
    if (PH(5)) for (int it = bx; it < 256; it += G) delta_scan(p, lds, (((it & 7) + 8 * (it >> 6)) << 3) + ((it >> 3) & 7), G);
    GRID_SYNC();

    if (PH(7)) {
        const int tid = fresh_tid(), lane = tid & 63, wave = tid >> 6;
        const float* od = (const float*)(ws + O_ODELTA); const bf16_t* gt = (const bf16_t*)(ws + O_GATE); bf16_t* mx = (bf16_t*)(ws + O_MIXED);
        const f32x4* og = (const f32x4*)(p.in[11] + (lane & 15) * 8);
        const f32x4 g0 = og[0], g1 = og[1];
        const bool lowh = (G == 256) && (bx < 128); const int rbeg = (G == 256) ? (lowh ? 0 : 5440) : 0, rend = (G == 256) ? (lowh ? 5440 : MT) : MT;
        const int rstep = (G == 256) ? 1024 : G * 8, rfirst = (G == 256) ? rbeg + (bx & 127) * 8 + wave : bx * 8 + wave;
        for (int r = rfirst; r < rend; r += rstep) {
            const f32x4* op = (const f32x4*)(od + (size_t)r * 512 + lane * 8); const f32x4 a = op[0], bq = op[1];
            float s = (a.x * a.x + a.y * a.y) + (a.z * a.z + a.w * a.w) + (bq.x * bq.x + bq.y * bq.y) + (bq.z * bq.z + bq.w * bq.w);
            s += __shfl_xor(s, 1); s += __shfl_xor(s, 2); s += __shfl_xor(s, 4); s += __shfl_xor(s, 8);
            const float rs = rsqrtf(s * (1.0f / 128.0f) + EPS);
            const u32x4 gw = *(const u32x4*)(gt + (size_t)r * 512 + lane * 8);
            u32x4 o;
            o.x = pk2(a.x * rs * g0.x * silu_f(bflo(gw.x)), a.y * rs * g0.y * silu_f(bfhi(gw.x)));
            o.y = pk2(a.z * rs * g0.z * silu_f(bflo(gw.y)), a.w * rs * g0.w * silu_f(bfhi(gw.y)));
            o.z = pk2(bq.x * rs * g1.x * silu_f(bflo(gw.z)), bq.y * rs * g1.y * silu_f(bfhi(gw.z)));
            o.w = pk2(bq.z * rs * g1.z * silu_f(bflo(gw.w)), bq.w * rs * g1.w * silu_f(bfhi(gw.w)));
            *(u32x4*)(mx + (size_t)r * 1024 + lane * 8) = o;
        }
    }
    if (PH(8)) {
        pg8::SchedPlain S{(const char*)(ws + O_YG), (const char*)(ws + O_WGLU), 512, 512, 64, 2, G, bx, 0, 256};
        pg8::EpiGlu E{(const bf16_t*)(ws + O_YG), p.in[21], (bf16_t*)(ws + O_MIXED)};
        pg8::gemm_phase(lds, 512, 512, 512, S, E);
    }
    GRID_SYNC();

    if (PH(9)) {
        pg8::SchedPlain S{(const char*)(ws + O_MIXED), (const char*)(ws + O_WOUT), 1024, 1024, 64, 4, G, bx, 0, 256};
        pg8::EpiRes E{p.in[0], X, XB, SSQ + 1 * MT, nullptr};
        pg8::gemm_phase(lds, 1024, 1024, 1024, S, E);
    }
    GRID_SYNC();

#pragma unroll 1
    for (int layer = p.l_lo; layer < p.l_hi; ++layer) {
        if (layer == 1) {
          if (PH(10)) {
            const int tid = fresh_tid();
            const float* ssq = SSQ + 3 * MT; const float* gm = p.in[2] + 1024; bf16_t* dp = (bf16_t*)(ws + O_DPOOL);
            for (int ui = 0; ; ++ui) { int tpm, tpn; if (!pg8::tile_order(ui, G, bx, 64, 4, tpm, tpn)) break;
                const int col = 256 * tpn + 4 * (tid & 63), w = 2 << tpn;
                const int r0 = 256 * tpm + 32 * (tid >> 6); const f32x4 gg = *(const f32x4*)(gm + col);
                f32x4 s = (f32x4){0.f, 0.f, 0.f, 0.f};
                {
                    f32x4 hx[15]; float hs[15];
#pragma unroll
                    for (int k = 1; k <= 15; ++k) { const bool ok = (k < w) && ((r0 & 2047) - k >= 0); const int rc = ok ? r0 - k : r0; hx[k - 1] = *(const f32x4*)(X + (size_t)rc * 1024 + col); hs[k - 1] = ld_ssq(ssq + rc); }
#pragma unroll
                    for (int k = 1; k <= 15; ++k) { const bool ok = (k < w) && ((r0 & 2047) - k >= 0); if (ok) s = s + hx[k - 1] * (rsqrtf(hs[k - 1] * (1.0f / 1024.0f) + EPS)) * gg; }
                }
#pragma unroll 1
                for (int bq = 0; bq < 4; ++bq) {
                    f32x4 nx[8], lx[8]; float ns[8], ls[8];
#pragma unroll
                    for (int i = 0; i < 8; ++i) { const int r = r0 + 8 * bq + i; nx[i] = *(const f32x4*)(X + (size_t)r * 1024 + col); ns[i] = ld_ssq(ssq + r);
                        const bool lok = ((r & 2047) - w + 1 >= 0); const int rl = lok ? r - w + 1 : r; lx[i] = *(const f32x4*)(X + (size_t)rl * 1024 + col); ls[i] = ld_ssq(ssq + rl); }
#pragma unroll
                    for (int i = 0; i < 8; ++i) { const int r = r0 + 8 * bq + i, ts = r & 2047;
                        const f32x4 xn = nx[i] * (rsqrtf(ns[i] * (1.0f / 1024.0f) + EPS)) * gg;
                        s = s + xn; const float inv = 1.0f / (float)(ts + 1 < w ? ts + 1 : w);
                        pg8::st_bf4(dp + (size_t)r * 1024 + col, s * inv - xn);
                        if (ts - w + 1 >= 0) s = s - lx[i] * (rsqrtf(ls[i] * (1.0f / 1024.0f) + EPS)) * gg; }
                }
            }
            asm volatile("s_waitcnt vmcnt(0)" ::: "memory"); __syncthreads();
          }
            if (PH(19)) {
                pg8::SchedPlain S{(const char*)(ws + O_DPOOL), (const char*)(ws + O_POOL), 1024, 256, 64, 4, G, bx, 256, 256};
                pg8::EpiRes E{X, X, XB, SSQ + 4 * MT, p.in[24]};
                pg8::gemm_phase(lds, 1024, 256, 256, S, E);
            }
            GRID_SYNC();
        }
        const int sx = layer == 0 ? 1 : 4;
        if (PH(11)) {
            pg8::SchedPlain S{(const char*)XB, (const char*)(ws + O_WQ + (size_t)layer * 2097152), 1024, 1024, 64, 4, G, bx, 0, 256};
            pg8::EpiScaleBf E{SSQ + sx * MT, (bf16_t*)(ws + O_Q), 1024, 0.0625f};
            pg8::gemm_phase(lds, 1024, 1024, 1024, S, E);
        }
        GRID_SYNC();
        if (PH(12)) {
            pg8::SchedAttn S{(const char*)(ws + O_Q), (const char*)(ws + O_KM + (size_t)layer * 4194304), 0, G, bx};
            pg8::EpiSoftmax E{(bf16_t*)(ws + O_P)};
            pg8::gemm_phase(lds, 1024, 1024, 256, S, E);
        }
        GRID_SYNC();
        if (PH(13)) {
            pg8::SchedAttn S{(const char*)(ws + O_P), (const char*)(ws + O_VT + (size_t)layer * 4194304), 1, G, bx};
            pg8::EpiScaleBf E{nullptr, (bf16_t*)(ws + O_O), 1024, 1.0f};
            pg8::gemm_phase(lds, 1024, 256, 256, S, E);
        }
        GRID_SYNC();
        if (PH(14)) {
            pg8::SchedPlain S{(const char*)(ws + O_O), (const char*)(ws + O_WO + (size_t)layer * 2097152), 1024, 1024, 64, 4, G, bx, 0, 256};
            pg8::EpiRes E{X, X, XB, SSQ + (sx + 1) * MT, nullptr};
            pg8::gemm_phase(lds, 1024, 1024, 1024, S, E);
        }
        GRID_SYNC();
        if (PH(15)) {
            pg8::SchedPlain S{(const char*)XB, (const char*)(ws + O_WUP + (size_t)layer * 11534336), 1024, 1024, 64, 22, G, bx, 0, 256};
            pg8::EpiUp E{SSQ + (sx + 1) * MT, p.in[29] + (size_t)layer * 3 * FF2, (bf16_t*)(ws + O_ACT), (float*)(ws + O_HALO)};
            pg8::gemm_phase(lds, 1024, 1024, 1024, S, E);
            if (layer == 0) {
                pg8::SchedKV S2{(const char*)(ws + O_MEMN), (const char*)(ws + O_WKV), 64, G == 256 ? bx - 128 : bx};
                pg8::EpiKV E2{(bf16_t*)(ws + O_KM), (bf16_t*)(ws + O_VT)};
                pg8::gemm_phase(lds, 1024, 1024, 1024, S2, E2);
            }
        }
        GRID_SYNC();
        if (PH(17)) {
            {
                const int tid = fresh_tid();
                const float* hl = (const float*)(ws + O_HALO); const float* cw = p.in[29] + (size_t)layer * 3 * FF2; bf16_t* act = (bf16_t*)(ws + O_ACT);
                for (int ui = 0; ; ++ui) { int pm, tpn; if (!pg8::tile_order(ui, G, bx, 64, 4, pm, tpn)) break;
                    if ((pm & 7) == 0) continue;
                    for (int ch = tid; ch < FF; ch += 512) {
                        const int pg = (ch >> 7) * 256 + (ch & 127), pv = pg + 128;
                        const float* hp = hl + (size_t)(pm - 1) * 4 * FF2; const float* hc = hl + (size_t)pm * 4 * FF2;
                        const float gm2 = hp[2 * FF2 + pg], gm1 = hp[3 * FF2 + pg], g0 = hc[pg], g1 = hc[FF2 + pg];
                        const float vm2 = hp[2 * FF2 + pv], vm1 = hp[3 * FF2 + pv], v0 = hc[pv], v1 = hc[FF2 + pv];
                        const float a0 = cw[ch], a1 = cw[FF2 + ch], a2 = cw[2 * FF2 + ch], b0 = cw[FF + ch], b1 = cw[FF2 + FF + ch], b2 = cw[2 * FF2 + FF + ch];
                        const float o0 = silu_f(a2 * g0 + a1 * gm1 + a0 * gm2) * (b2 * v0 + b1 * vm1 + b0 * vm2);
                        const float o1 = silu_f(a2 * g1 + a1 * g0 + a0 * gm1) * (b2 * v1 + b1 * v0 + b0 * vm1);
                        act[(size_t)(pm * 256) * FF + ch] = (bf16_t)f2bf(o0); act[(size_t)(pm * 256 + 1) * FF + ch] = (bf16_t)f2bf(o1);
                    }
                }
                asm volatile("s_waitcnt vmcnt(0)" ::: "memory"); __syncthreads();
            }
            pg8::SchedPlain S{(const char*)(ws + O_ACT), (const char*)(ws + O_WDN + (size_t)layer * 5767168), FF, FF, 64, 4, G, bx, 0, 256};
            pg8::EpiRes E{X, X, nullptr, SSQ + (sx + 2) * MT, nullptr};
            pg8::gemm_phase(lds, FF, FF, FF, S, E);
        }
        GRID_SYNC();
    }
    if (PH(18)) {
        const int tid = fresh_tid(), lane = tid & 63, wave = tid >> 6;
        const float* ssq = SSQ + 6 * MT; const f32x4* gf = (const f32x4*)p.in[6] + lane;
        f32x4 gq[4];
#pragma unroll
        for (int j = 0; j < 4; ++j) gq[j] = gf[64 * j];
        const int st8 = G * 8;
        for (int r = bx * 8 + wave; r < MT; r += 2 * st8) {
            const int r2 = r + st8 < MT ? r + st8 : r; const bool two = r + st8 < MT;
            f32x4* xp = (f32x4*)(X + (size_t)r * 1024) + lane; f32x4* xq = (f32x4*)(X + (size_t)r2 * 1024) + lane;
            f32x4 a[4], bq[4]; const float sa = ld_ssq(ssq + r), sb = ld_ssq(ssq + r2);
#pragma unroll
            for (int j = 0; j < 4; ++j) { a[j] = xp[64 * j]; bq[j] = xq[64 * j]; }
            const float ra = rsqrtf(sa * (1.0f / 1024.0f) + EPS), rb = rsqrtf(sb * (1.0f / 1024.0f) + EPS);
#pragma unroll
            for (int j = 0; j < 4; ++j) xp[64 * j] = a[j] * ra * gq[j];
            if (two) {
#pragma unroll
                for (int j = 0; j < 4; ++j) xq[64 * j] = bq[j] * rb * gq[j];
            }
            if (PROBE_A >= 0) {
                const float dA = (float)(tsbuf[PROBE_A] - tsbuf[0]) * 1e-4f, eB = (float)(tsbuf[PROBE_B] - tsbuf[0]) * 1e-2f;
#pragma unroll
                for (int j = 0; j < 4; ++j) xp[64 * j] = xp[64 * j] + dA;
                if (r == 0 && lane == 0) { f32x4 v = xp[0]; v.x += eB; xp[0] = v; }
            }
        }
    }
}

#ifndef MULTI_LAUNCH
#define MULTI_LAUNCH 0
#endif
template <int K> static void launch_phase(const Params& p, int lo, int hi, int grid, hipStream_t stream) {
    static bool attr = false;
    if (!attr) { (void)hipFuncSetAttribute((const void*)fwd_kernel<K>, hipFuncAttributeMaxDynamicSharedMemorySize, LDS_BYTES); attr = true; }
    Params q = p; q.l_lo = lo; q.l_hi = hi;
    hipLaunchKernelGGL(fwd_kernel<K>, dim3(grid), dim3(512), LDS_BYTES, stream, q);
}
extern "C" void kernel_launch(void* const* d_in, const int* in_sizes, int n_in, void* d_out, int out_size, void* d_ws, size_t ws_size, hipStream_t stream) {
    Params p{};
    for (int i = 0; i < 31; ++i) p.in[i] = (const float*)d_in[i];
    p.out = (float*)d_out; p.ws = (unsigned char*)d_ws; p.l_lo = 0; p.l_hi = 2;
#if MULTI_LAUNCH
    const int g = 256;
    launch_phase<0>(p, 0, 0, g, stream); launch_phase<1>(p, 0, 0, g, stream); launch_phase<2>(p, 0, 0, g, stream); launch_phase<3>(p, 0, 0, g, stream);
    launch_phase<4>(p, 0, 0, g, stream); launch_phase<5>(p, 0, 0, g, stream); launch_phase<6>(p, 0, 0, g, stream); launch_phase<7>(p, 0, 0, g, stream);
    launch_phase<8>(p, 0, 0, g, stream); launch_phase<9>(p, 0, 0, g, stream);
    for (int l = 0; l < 2; ++l) {
        if (l == 1) { launch_phase<10>(p, 1, 2, g, stream); launch_phase<19>(p, 1, 2, g, stream); }
        launch_phase<11>(p, l, l + 1, g, stream); launch_phase<12>(p, l, l + 1, g, stream); launch_phase<13>(p, l, l + 1, g, stream); launch_phase<14>(p, l, l + 1, g, stream);
        launch_phase<15>(p, l, l + 1, g, stream); launch_phase<16>(p, l, l + 1, g, stream); launch_phase<17>(p, l, l + 1, g, stream);
    }
    launch_phase<18>(p, 0, 0, g, stream);
#else
    static int grid_blocks = 0;
    if (!grid_blocks) {
        int dev = 0, cus = 0, per_cu = 0;
        (void)hipGetDevice(&dev);
        (void)hipDeviceGetAttribute(&cus, hipDeviceAttributeMultiprocessorCount, dev);
        (void)hipFuncSetAttribute((const void*)fwd_kernel<-1>, hipFuncAttributeMaxDynamicSharedMemorySize, LDS_BYTES);
        (void)hipOccupancyMaxActiveBlocksPerMultiprocessor(&per_cu, (const void*)fwd_kernel<-1>, 512, LDS_BYTES);
        if (per_cu < 1) { fprintf(stderr, "occupancy query returned %d\n", per_cu); per_cu = 1; }
        grid_blocks = cus * per_cu;
        if (grid_blocks > 256) grid_blocks = 256;
    }
    (void)hipMemsetAsync((char*)d_ws + O_BAR, 0, 16384, stream);
    void* args[] = {&p};
    hipError_t e = hipLaunchCooperativeKernel((const void*)fwd_kernel<-1>, dim3(grid_blocks), dim3(512), args, LDS_BYTES, stream);
    if (e != hipSuccess) fprintf(stderr, "cooperative launch failed: %s (grid %d)\n", hipGetErrorString(e), grid_blocks);
#endif
}
```
